# Optimizing an MI355X kernel written in HIP

```python
import jax, jax.numpy as jnp
from jax import lax
import numpy as np

D_MODEL = 1024
BATCH = 2
SEQ = 8192
DEPTH = 1

MLA_HEADS = 8
MLA_Q_LORA = 384
MLA_KV_LORA = 256
MLA_NOPE = 64
MLA_ROPE = 32
MLA_V = 64
MLA_W = MLA_HEADS * MLA_V
ROPE_THETA = 10000.0
Q_BLOCK = 128
MLSTM_HEADS = 4
MLSTM_DH = 128
MLSTM_W = MLSTM_HEADS * MLSTM_DH
MLSTM_CHUNK = 64
CONV_WIDTH = 5
D_FF = 4 * D_MODEL
NORM_EPS = 1e-6
IN_SPLITS = (MLA_Q_LORA, MLA_KV_LORA, MLA_ROPE, MLSTM_W, MLSTM_W, MLSTM_W, MLSTM_W, 4 * MLSTM_HEADS, D_MODEL, D_MODEL)
IN_COLS = MLA_Q_LORA + MLA_KV_LORA + MLA_ROPE + 4 * MLSTM_W + 4 * MLSTM_HEADS + 2 * D_MODEL

kernel_name = "hybrid_mla_mlstm_gated_block"


def rmsnorm(x, g):
    xf = x.astype(jnp.float32)
    y = xf * lax.rsqrt(jnp.mean(xf * xf, axis=-1, keepdims=True) + NORM_EPS)
    return (y * g.astype(jnp.float32)).astype(x.dtype)


def split_cols(h):
    outs, off = [], 0
    for w in IN_SPLITS:
        outs.append(h[..., off:off + w])
        off += w
    return outs


def rope_tables(positions):
    inv_freq = ROPE_THETA ** (-jnp.arange(0, MLA_ROPE, 2, dtype=jnp.float32) / MLA_ROPE)
    ang = positions.astype(jnp.float32)[..., None] * inv_freq
    return jnp.cos(ang), jnp.sin(ang)


def apply_rope(x, cos, sin):
    xf = x.astype(jnp.float32)
    half = xf.shape[-1] // 2
    x1, x2 = xf[..., :half], xf[..., half:]
    return jnp.concatenate([x1 * cos - x2 * sin, x2 * cos + x1 * sin], axis=-1).astype(x.dtype)


def mla_attention(q_nope, q_rope, k_nope, k_rope, v):
    B, S, H, _ = q_nope.shape
    nb = S // Q_BLOCK
    scale = (MLA_NOPE + MLA_ROPE) ** -0.5
    qn = q_nope.reshape(B, nb, Q_BLOCK, H, MLA_NOPE).swapaxes(0, 1)
    qr = q_rope.reshape(B, nb, Q_BLOCK, H, MLA_ROPE).swapaxes(0, 1)
    kn = k_nope.astype(jnp.float32)
    kr = k_rope.astype(jnp.float32)
    vf = v.astype(jnp.float32)

    def block(args):
        qn_b, qr_b = args
        s = (jnp.einsum('bqhd,bkhd->bhqk', qn_b.astype(jnp.float32), kn)
             + jnp.einsum('bqhd,bkd->bhqk', qr_b.astype(jnp.float32), kr))
        p = jax.nn.softmax(s * scale, axis=-1)
        return jnp.einsum('bhqk,bkhd->bqhd', p, vf)

    o = lax.map(block, (qn, qr))
    return o.swapaxes(0, 1).reshape(B, S, H * MLA_V).astype(v.dtype)


def mla_branch(c_q, c_kv, k_rope_raw, cos, sin, q_norm_g, w_uq, kv_norm_g, w_ukv):
    B, S, _ = c_q.shape
    q = (rmsnorm(c_q, q_norm_g) @ w_uq).reshape(B, S, MLA_HEADS, MLA_NOPE + MLA_ROPE)
    q_nope = q[..., :MLA_NOPE]
    q_rope = apply_rope(q[..., MLA_NOPE:], cos[:, :, None, :], sin[:, :, None, :])
    k_rope = apply_rope(k_rope_raw, cos, sin)
    kv = (rmsnorm(c_kv, kv_norm_g) @ w_ukv).reshape(B, S, MLA_HEADS, MLA_NOPE + MLA_V)
    k_nope, v = kv[..., :MLA_NOPE], kv[..., MLA_NOPE:]
    return mla_attention(q_nope, q_rope, k_nope, k_rope, v)


def mlstm_chunkwise(q, k, v, i_pre, f_pre):
    B, H, S, DK = q.shape
    DV = v.shape[-1]
    L = MLSTM_CHUNK
    NC = S // L
    qc = q.astype(jnp.float32).reshape(B, H, NC, L, DK)
    kc = k.astype(jnp.float32).reshape(B, H, NC, L, DK) * (DK ** -0.5)
    vc = v.astype(jnp.float32).reshape(B, H, NC, L, DV)
    log_f = jax.nn.log_sigmoid(f_pre.astype(jnp.float32)).reshape(B, H, NC, L)
    log_i = i_pre.astype(jnp.float32).reshape(B, H, NC, L)
    b = jnp.cumsum(log_f, axis=-1)
    b_last = b[..., -1]
    w_end = b_last[..., None] - b + log_i

    def step(carry, inp):
        C, n, m = carry
        k_c, v_c, w_c, bl = inp
        m_new = jnp.maximum(bl + m, jnp.max(w_c, axis=-1))
        decay = jnp.exp(bl + m - m_new)
        w = jnp.exp(w_c - m_new[..., None])
        C_new = decay[..., None, None] * C + jnp.einsum('bhl,bhlk,bhlv->bhkv', w, k_c, v_c)
        n_new = decay[..., None] * n + jnp.einsum('bhl,bhlk->bhk', w, k_c)
        return (C_new, n_new, m_new), (C, n, m)

    init = (jnp.zeros((B, H, DK, DV), jnp.float32), jnp.zeros((B, H, DK), jnp.float32),
            jnp.zeros((B, H), jnp.float32))
    xs = (jnp.moveaxis(kc, 2, 0), jnp.moveaxis(vc, 2, 0), jnp.moveaxis(w_end, 2, 0), jnp.moveaxis(b_last, 2, 0))
    _, (C_prev, n_prev, m_prev) = lax.scan(step, init, xs)
    C_prev = jnp.moveaxis(C_prev, 0, 2)
    n_prev = jnp.moveaxis(n_prev, 0, 2)
    m_prev = jnp.moveaxis(m_prev, 0, 2)

    mask = jnp.tril(jnp.ones((L, L), dtype=bool))
    D = jnp.where(mask, b[..., :, None] - b[..., None, :] + log_i[..., None, :], -jnp.inf)
    inter_log = b + m_prev[..., None]
    m_t = jnp.maximum(inter_log, jnp.max(D, axis=-1))
    inter_w = jnp.exp(inter_log - m_t)
    qk = jnp.einsum('bhctd,bhcsd->bhcts', qc, kc) * jnp.exp(D - m_t[..., None])
    num = inter_w[..., None] * jnp.einsum('bhctk,bhckv->bhctv', qc, C_prev) + jnp.einsum('bhcts,bhcsv->bhctv', qk, vc)
    den = inter_w * jnp.einsum('bhctk,bhck->bhct', qc, n_prev) + jnp.sum(qk, axis=-1)
    h = num / jnp.maximum(jnp.abs(den), jnp.exp(-m_t))[..., None]
    return h.reshape(B, H, S, DV)


def mlstm_branch(mq, mk, mv, mo, mgates, conv_w, conv_b, ig_b, fg_b, out_norm_g):
    B, S, _ = mq.shape
    qk = jnp.concatenate([mq, mk], axis=-1)
    qk = lax.conv_general_dilated(qk, conv_w, window_strides=(1,),
                                  padding=[(CONV_WIDTH // 2, CONV_WIDTH // 2)],
                                  dimension_numbers=('NWC', 'WIO', 'NWC'),
                                  feature_group_count=2 * MLSTM_W) + conv_b
    qk = jax.nn.silu(qk)

    def heads(t):
        return t.reshape(B, S, MLSTM_HEADS, MLSTM_DH).transpose(0, 2, 1, 3)

    q, k, v = heads(qk[..., :MLSTM_W]), heads(qk[..., MLSTM_W:]), heads(mv)
    g = mgates.reshape(B, S, 2, 2, MLSTM_HEADS)
    i_pre = (g[:, :, :, 0, :] + ig_b).transpose(2, 0, 3, 1)
    f_pre = (g[:, :, :, 1, :] + fg_b).transpose(2, 0, 3, 1)
    h_fwd = mlstm_chunkwise(q, k, v, i_pre[0], f_pre[0])
    h_bwd = jnp.flip(mlstm_chunkwise(jnp.flip(q, 2), jnp.flip(k, 2), jnp.flip(v, 2),
                                     jnp.flip(i_pre[1], -1), jnp.flip(f_pre[1], -1)), 2)
    h = h_fwd + h_bwd
    h = h * lax.rsqrt(jnp.mean(h * h, axis=-1, keepdims=True) + NORM_EPS)
    h = h.transpose(0, 2, 1, 3).reshape(B, S, MLSTM_W) * out_norm_g.astype(jnp.float32)
    return (h * jax.nn.sigmoid(mo.astype(jnp.float32))).astype(mq.dtype)


def setup_inputs(seed: int = 0) -> dict:
    key = jax.random.key(seed)
    ks = jax.random.split(key, 24)

    def nrm(k, shape, fan_in):
        return jax.random.normal(k, shape, jnp.float32) * (fan_in ** -0.5)

    def gain(k, shape):
        return 1.0 + 0.02 * jax.random.normal(k, shape, jnp.float32)

    x = jax.random.normal(ks[0], (BATCH, SEQ, D_MODEL), jnp.float32)
    offset = jax.random.randint(ks[1], (BATCH, 1), 0, 1024, dtype=jnp.int32)
    positions = jnp.arange(SEQ, dtype=jnp.int32)[None, :] + offset
    fgate_base = jnp.linspace(3.0, 6.0, MLSTM_HEADS, dtype=jnp.float32)
    return {
        "x": x,
        "positions": positions,
        "norm_mix_g": gain(ks[2], (DEPTH, D_MODEL)),
        "w_in": nrm(ks[3], (DEPTH, D_MODEL, IN_COLS), D_MODEL),
        "mla_q_norm_g": gain(ks[4], (DEPTH, MLA_Q_LORA)),
        "mla_w_uq": nrm(ks[5], (DEPTH, MLA_Q_LORA, MLA_HEADS * (MLA_NOPE + MLA_ROPE)), MLA_Q_LORA),
        "mla_kv_norm_g": gain(ks[6], (DEPTH, MLA_KV_LORA)),
        "mla_w_ukv": nrm(ks[7], (DEPTH, MLA_KV_LORA, MLA_HEADS * (MLA_NOPE + MLA_V)), MLA_KV_LORA),
        "mlstm_conv_w": nrm(ks[8], (DEPTH, CONV_WIDTH, 1, 2 * MLSTM_W), CONV_WIDTH),
        "mlstm_conv_b": 0.02 * jax.random.normal(ks[9], (DEPTH, 2 * MLSTM_W), jnp.float32),
        "mlstm_igate_b": 0.1 * jax.random.normal(ks[10], (DEPTH, 2, MLSTM_HEADS), jnp.float32),
        "mlstm_fgate_b": fgate_base + 0.1 * jax.random.normal(ks[11], (DEPTH, 2, MLSTM_HEADS), jnp.float32),
        "mlstm_out_norm_g": gain(ks[12], (DEPTH, MLSTM_W)),
        "w_branch_mla": nrm(ks[13], (DEPTH, MLA_W, D_MODEL), MLA_W),
        "w_branch_mlstm": nrm(ks[14], (DEPTH, MLSTM_W, D_MODEL), MLSTM_W),
        "w_out": nrm(ks[15], (DEPTH, D_MODEL, D_MODEL), D_MODEL),
        "norm_mlp_g": gain(ks[16], (DEPTH, D_MODEL)),
        "w_mlp_up": nrm(ks[17], (DEPTH, D_MODEL, D_FF), D_MODEL),
        "w_mlp_down": nrm(ks[18], (DEPTH, D_FF, D_MODEL), D_FF),
        "norm_final_g": gain(ks[19], (D_MODEL,)),
    }


def reference(x, positions, norm_mix_g, w_in, mla_q_norm_g, mla_w_uq, mla_kv_norm_g, mla_w_ukv,
              mlstm_conv_w, mlstm_conv_b, mlstm_igate_b, mlstm_fgate_b, mlstm_out_norm_g,
              w_branch_mla, w_branch_mlstm, w_out, norm_mlp_g, w_mlp_up, w_mlp_down, norm_final_g):
    cos, sin = rope_tables(positions)
    for l in range(DEPTH):
        h = rmsnorm(x, norm_mix_g[l])
        c_q, c_kv, k_rope, mq, mk, mv, mo, mgates, gate_a, gate_b = split_cols(h @ w_in[l])
        y_attn = mla_branch(c_q, c_kv, k_rope, cos, sin, mla_q_norm_g[l], mla_w_uq[l],
                            mla_kv_norm_g[l], mla_w_ukv[l])
        y_mlstm = mlstm_branch(mq, mk, mv, mo, mgates, mlstm_conv_w[l], mlstm_conv_b[l],
                               mlstm_igate_b[l], mlstm_fgate_b[l], mlstm_out_norm_g[l])
        merged = (jax.nn.sigmoid(gate_a) * (y_attn @ w_branch_mla[l])
                  + jax.nn.sigmoid(gate_b) * (y_mlstm @ w_branch_mlstm[l]))
        x = x + merged @ w_out[l]
        u = rmsnorm(x, norm_mlp_g[l]) @ w_mlp_up[l]
        x = x + jnp.square(jax.nn.relu(u)) @ w_mlp_down[l]
    return rmsnorm(x, norm_final_g)
```

```cpp
#include <hip/hip_runtime.h>
#include <hip/hip_bf16.h>
#include <cstdio>
#include <cstdint>

#ifndef PROBE_DUP
#define PROBE_DUP 0
#endif
#ifndef MK_SPLIT
#define MK_SPLIT 0
#endif

#define LAS __attribute__((address_space(3)))
#define GAS __attribute__((address_space(1)))
typedef unsigned short bf16_t;
typedef short bf16x8 __attribute__((ext_vector_type(8)));
typedef short s16x4 __attribute__((ext_vector_type(4)));
typedef float f32x4 __attribute__((ext_vector_type(4)));
typedef float f32x16 __attribute__((ext_vector_type(16)));
typedef unsigned u32x4 __attribute__((ext_vector_type(4)));
typedef unsigned u32x2 __attribute__((ext_vector_type(2)));
typedef float f32x2_t __attribute__((ext_vector_type(2)));
typedef __bf16 bf16x2_t __attribute__((ext_vector_type(2)));

constexpr int BATCH = 2, SEQ = 8192, DMODEL = 1024, M = BATCH * SEQ;
constexpr int IN_COLS = 4784, NIN = 4864;
constexpr int DFF = 4096;
constexpr float NORM_EPS = 1e-6f;
constexpr int NWAVES = 8;
constexpr int NPHASE = 10;

constexpr size_t MiB = 1u << 20;
constexpr size_t WS_CTL = 0, CTL_ZERO_BYTES = 128 * 1024;
constexpr size_t WS_WIN = 1 * MiB;
constexpr size_t WS_WUQ = WS_WIN + (size_t)NIN * 1024 * 2;
constexpr size_t WS_WUKV = WS_WUQ + 768 * 384 * 2;
constexpr size_t WS_WBM = 12 * MiB, WS_WBL = 13 * MiB, WS_WOUT = 14 * MiB, WS_WUP = 16 * MiB, WS_WDN = 24 * MiB;
constexpr size_t WS_ROPE = 32 * MiB;
constexpr size_t WS_SSQ = 34 * MiB;
constexpr size_t WS_SSQ1 = WS_SSQ + 24 * (size_t)M * 4;
constexpr size_t WS_SSQ2 = WS_SSQ1 + 16 * (size_t)M * 4;
constexpr size_t WS_G32 = WS_SSQ2 + 16 * (size_t)M * 4;
constexpr size_t WS_UN = WS_G32 + (size_t)M * 16 * 4;
constexpr size_t WS_BL = WS_UN + 16 * 128 * 128 * 4;
constexpr size_t WS_ML = WS_BL + 16 * 128 * 4;
constexpr size_t WS_MP = WS_ML + 16 * 128 * 4;
static_assert(WS_MP + 16 * 128 * 4 <= 40 * MiB, "misc region");
static_assert(WS_WUKV + 1024 * 256 * 2 <= WS_WBM, "weights");
constexpr size_t WS_H0 = 40 * MiB, WS_HQK = 64 * MiB, WS_HVO = 96 * MiB, WS_HG = 128 * MiB;
constexpr size_t WS_R = 192 * MiB;
constexpr size_t WS_XN = WS_R, WS_UC = WS_R, WS_QC = WS_R + 16 * MiB, WS_KC = WS_R + 32 * MiB, WS_VTG = WS_R + 48 * MiB, WS_G1 = WS_R, WS_MERGED = WS_R + 32 * MiB, WS_X1B = WS_R;
constexpr size_t WS_ACT = 40 * MiB;
constexpr size_t WS_YA = 40 * MiB;
constexpr size_t WS_YM = WS_HVO + 512 * 2;
constexpr size_t WS_END = 256 * MiB;
constexpr size_t DO_Q = 0, DO_KV = 24 * MiB, DO_KR = 56 * MiB;
constexpr int CW_BAR = 4096, CW_CNT = 16384, CW_P5 = 24576, CW_G2 = 24704, CW_G0 = 24768, CW_S3 = 24832, CW_G1 = 25920;
static_assert((CW_BAR + 3456) * 4 <= 128 * 1024 && (CW_CNT + 64 * 64) * 4 <= 128 * 1024, "control words inside the per-call memset");

__device__ __forceinline__ unsigned pk2(float lo, float hi) { f32x2_t v = {lo, hi}; bf16x2_t b = __builtin_convertvector(v, bf16x2_t); return __builtin_bit_cast(unsigned, b); }
__device__ __forceinline__ float bflo(unsigned w) { return __uint_as_float(w << 16); }
__device__ __forceinline__ float bfhi(unsigned w) { return __uint_as_float(w & 0xffff0000u); }
__device__ __forceinline__ float bf2f(bf16_t h) { return __uint_as_float((unsigned)h << 16); }
__device__ __forceinline__ float sigmoidf_(float x) { return __builtin_amdgcn_rcpf(1.f + __expf(-x)); }
__device__ __forceinline__ float dot4(f32x4 a) { return (a[0] * a[0] + a[1] * a[1]) + (a[2] * a[2] + a[3] * a[3]); }
#define LDS_WAIT() asm volatile("s_waitcnt lgkmcnt(0)" ::: "memory")
#define VM_WAIT() asm volatile("s_waitcnt vmcnt(0)" ::: "memory")

namespace pg8 {
#define PG8_LAS __attribute__((address_space(3)))
constexpr int BM = 256, BK = 64, HALF = 128, HTB = HALF * BK * 2, STAGE_BYTES = 8 * HTB, NXCD = 8, WGM = 8;
__host__ __device__ __forceinline__ int lds_byte(int r, int c) { const int st = (r >> 4) * 2 + (c >> 5), rr = r & 15, cc = c & 31, ob = rr * 64 + cc * 2; return st * 1024 + (ob ^ (((ob >> 9) & 1) << 5)); }
__host__ __device__ __forceinline__ void stage_rc(int b, int& R, int& C) { const int st = b / 1024, sb = b % 1024, swz = sb ^ (((sb >> 9) & 1) << 5); R = (st >> 1) * 16 + swz / 64; C = (st & 1) * 32 + (swz % 64) / 2; }
__host__ __device__ __forceinline__ int perm32(int rho) { const int n = rho >> 4, i = rho & 15; return 8 * (i >> 2) + 4 * n + (i & 3); }
struct Unit { int pm, pn; };
struct Gemm { const bf16_t* A; const bf16_t* Bt; int M, N, K, lda, ldb; };
struct StaticOrder {
    int nM, nN, nwg, G, c;
    __host__ __device__ void init(int M_, int N_, int G_, int c_) { nM = M_ / BM; nN = N_ / BM; nwg = nM * nN; G = G_; c = c_; }
    __host__ __device__ bool next(int i, Unit& u) const {
        const long L = (long)i * G + c; if (L >= nwg) return false;
        int wgid = (int)L; { const int q = nwg / NXCD, r = nwg % NXCD, xcd = wgid % NXCD, off = wgid / NXCD; wgid = (xcd < r ? xcd * (q + 1) : r * (q + 1) + (xcd - r) * q) + off; }
        const int nig = WGM * nN, gid = wgid / nig, fm = gid * WGM, gsz = (nM - fm) < WGM ? (nM - fm) : WGM;
        u.pm = fm + ((wgid % nig) % gsz); u.pn = (wgid % nig) / gsz; return true;
    }
};
template <class Epi, class Sched>
__device__ __forceinline__ void gemm_phase(PG8_LAS unsigned char* lds, const Gemm g, const Sched& S, const Epi& E) {
    const int tid = threadIdx.x, wid = __builtin_amdgcn_readfirstlane(tid >> 6), lane = tid & 63, wr = wid >> 2, wc = wid & 3, fr = lane & 15, fq = lane >> 4;
    const int K = g.K, nt = K / BK;
    unsigned voffA[2], voffB[2];
#pragma unroll
    for (int i = 0; i < 2; ++i) { int R, C; stage_rc(tid * 16 + i * 8192, R, C); const int Rb = (R & ~31) + perm32(R & 31);
        voffA[i] = (unsigned)(R * g.lda + C) * 2u; voffB[i] = (unsigned)(Rb * g.ldb + C) * 2u; }
    const size_t kstep = (size_t)(BK * 2);
    const size_t hstepA = (size_t)HALF * g.lda * 2, hstepB = (size_t)HALF * g.ldb * 2;
    const size_t tstepA = 2 * hstepA, tstepB = 2 * hstepB;
    const unsigned ldsw = (unsigned)wid * 1024u;
    const int aoff = lds_byte(wr * 64 + fr, fq * 8), boff = lds_byte(wc * 32 + fr, fq * 8);
#define PG8_SA(b, h) (((b) * 2 + (h)) * HTB)
#define PG8_SB(b, h) ((4 + (b) * 2 + (h)) * HTB)
#define PG8_STAGE(bufoff, gbase, voff) do { _Pragma("unroll") for (int _i = 0; _i < 2; ++_i) \
        __builtin_amdgcn_global_load_lds((const unsigned*)((const char*)(gbase) + (voff)[_i]), (PG8_LAS unsigned*)(lds + (bufoff) + ldsw + _i * 8192), 16, 0, 0); } while (0)
#define PG8_LDA(dst, b, h) do { _Pragma("unroll") for (int m = 0; m < 4; ++m) _Pragma("unroll") for (int k = 0; k < 2; ++k) dst[m][k] = *(const PG8_LAS bf16x8*)(lds + PG8_SA(b, h) + aoff + m * 2048 + k * 1024); } while (0)
#define PG8_LDB(dst, b, h) do { _Pragma("unroll") for (int n = 0; n < 2; ++n) _Pragma("unroll") for (int k = 0; k < 2; ++k) dst[n][k] = *(const PG8_LAS bf16x8*)(lds + PG8_SB(b, h) + boff + n * 2048 + k * 1024); } while (0)
#define PG8_MMA(ai, bj, At, Bt) do { __builtin_amdgcn_s_setprio(1); _Pragma("unroll") for (int m = 0; m < 4; ++m) _Pragma("unroll") for (int n = 0; n < 2; ++n) _Pragma("unroll") for (int k = 0; k < 2; ++k) \
        acc[ai][bj][m][n] = __builtin_amdgcn_mfma_f32_16x16x32_bf16(Bt[n][k], At[m][k], acc[ai][bj][m][n], 0, 0, 0); __builtin_amdgcn_s_setprio(0); } while (0)
#define PG8_WAIT_V(n) asm volatile("s_waitcnt vmcnt(" #n ")" ::: "memory")
#define PG8_WAIT_L(n) asm volatile("s_waitcnt lgkmcnt(" #n ")" ::: "memory")
#define PG8_BAR __builtin_amdgcn_s_barrier()
#define PG8_SCHED __builtin_amdgcn_sched_barrier(0)
    Unit cur, nxt; int ui = 0;
    if (!S.next(0, cur)) return;
    f32x4 acc[2][2][4][2];
#pragma unroll
    for (int a = 0; a < 2; ++a)
#pragma unroll
        for (int b = 0; b < 2; ++b)
#pragma unroll
            for (int m = 0; m < 4; ++m)
#pragma unroll
                for (int n = 0; n < 2; ++n) acc[a][b][m][n] = (f32x4){0.f, 0.f, 0.f, 0.f};
    bf16x8 At[4][2], B0[2][2], B1[2][2];
    const char* cA = (const char*)g.A + (size_t)cur.pm * tstepA; const char* cB = (const char*)g.Bt + (size_t)cur.pn * tstepB;
    PG8_STAGE(PG8_SB(0, 0), cB, voffB); PG8_STAGE(PG8_SB(0, 1), cB + hstepB, voffB); PG8_STAGE(PG8_SA(0, 0), cA, voffA); PG8_STAGE(PG8_SA(0, 1), cA + hstepA, voffA);
    if (wr == 1) PG8_BAR;
    PG8_WAIT_V(2); PG8_BAR;
    PG8_STAGE(PG8_SB(1, 0), cB + kstep, voffB); PG8_STAGE(PG8_SA(1, 0), cA + kstep, voffA); PG8_STAGE(PG8_SB(1, 1), cB + hstepB + kstep, voffB);
    PG8_WAIT_V(6); PG8_BAR;
    if constexpr (Epi::HAS_INIT) E.init(acc, cur, wr, wc, fr, fq);
    for (;;) {
        const bool has_next = S.next(ui + 1, nxt);
        const char* nA = has_next ? (const char*)g.A + (size_t)nxt.pm * tstepA : cA; const char* nB = has_next ? (const char*)g.Bt + (size_t)nxt.pn * tstepB : cB;
#pragma unroll 1
        for (int t = 0; t < nt; t += 2) {
            if constexpr (Epi::HAS_MID) { if (t == (nt >> 1)) { E.mid(acc, cur, wr, wc, fr, fq); PG8_SCHED; } }
            const bool last = (t == nt - 2);
            size_t d1 = 0, d2 = 0; if constexpr (Epi::HAS_A2) { d1 = (t + 1 >= (nt >> 1)) ? E.a2delta : 0; d2 = (t + 2 >= (nt >> 1)) ? E.a2delta : 0; }
            const char* a1 = cA + (size_t)(t + 1) * kstep + d1;
            const char* a2 = last ? nA : cA + (size_t)(t + 2) * kstep + d2; const char* b2 = last ? nB : cB + (size_t)(t + 2) * kstep;
            const char* a3 = a2 + kstep; const char* b3 = b2 + kstep;
            PG8_LDB(B0, 0, 0); PG8_LDB(B1, 0, 1); PG8_SCHED; PG8_LDA(At, 0, 0); PG8_STAGE(PG8_SA(1, 1), a1 + hstepA, voffA);
            PG8_WAIT_V(8); PG8_WAIT_L(0); PG8_BAR; PG8_MMA(0, 0, At, B0); PG8_MMA(0, 1, At, B1); PG8_BAR; PG8_SCHED;
            PG8_LDA(At, 0, 1); PG8_STAGE(PG8_SB(0, 0), b2, voffB); PG8_STAGE(PG8_SB(0, 1), b2 + hstepB, voffB); PG8_STAGE(PG8_SA(0, 0), a2, voffA);
            PG8_WAIT_V(8); PG8_WAIT_L(0); PG8_BAR; PG8_MMA(1, 0, At, B0); PG8_MMA(1, 1, At, B1); PG8_BAR; PG8_SCHED;
            PG8_LDB(B0, 1, 0); PG8_LDB(B1, 1, 1); PG8_SCHED; PG8_LDA(At, 1, 0); PG8_STAGE(PG8_SA(0, 1), a2 + hstepA, voffA);
            PG8_WAIT_V(8); PG8_WAIT_L(0); PG8_BAR; PG8_MMA(0, 0, At, B0); PG8_MMA(0, 1, At, B1); PG8_BAR; PG8_SCHED;
            PG8_LDA(At, 1, 1); PG8_STAGE(PG8_SB(1, 0), b3, voffB); PG8_STAGE(PG8_SB(1, 1), b3 + hstepB, voffB); PG8_STAGE(PG8_SA(1, 0), a3, voffA);
            PG8_WAIT_V(8); PG8_WAIT_L(0); PG8_BAR; PG8_MMA(1, 0, At, B0); PG8_MMA(1, 1, At, B1); PG8_BAR; PG8_SCHED;
        }
        if (wr == 0) PG8_BAR;
        if constexpr (Epi::HAS_PREP) { E.prep(cur, lds + STAGE_BYTES + 1024, tid); PG8_WAIT_L(0); PG8_BAR; }
        if constexpr (Epi::FINAL) E.fused(acc, cur, wr, wc, fr, fq, lds + STAGE_BYTES + 1024, tid);
        else E(acc, cur, wr, wc, fr, fq, lds + STAGE_BYTES + 1024);
        if (!has_next) break;
#pragma unroll
        for (int a = 0; a < 2; ++a)
#pragma unroll
            for (int b = 0; b < 2; ++b)
#pragma unroll
                for (int m = 0; m < 4; ++m)
#pragma unroll
                    for (int n = 0; n < 2; ++n) acc[a][b][m][n] = (f32x4){0.f, 0.f, 0.f, 0.f};
        cur = nxt; cA = nA; cB = nB; ++ui;
        if constexpr (Epi::HAS_INIT) E.init(acc, cur, wr, wc, fr, fq);
        if (wr == 1) PG8_BAR;
    }
    PG8_WAIT_V(0);
    PG8_BAR;
#undef PG8_SA
#undef PG8_SB
#undef PG8_STAGE
#undef PG8_LDA
#undef PG8_LDB
#undef PG8_MMA
#undef PG8_WAIT_V
#undef PG8_WAIT_L
#undef PG8_BAR
#undef PG8_SCHED
}
}

#define EPI_ROWS_BEGIN  _Pragma("unroll") for (int ai = 0; ai < 2; ++ai) _Pragma("unroll") for (int m = 0; m < 4; ++m) { const int row = row0 + ai * 128 + m * 16;
#define EPI_ROWS_END    asm volatile("" ::: "memory"); }
#define EPI_HALF_BEGIN  _Pragma("unroll") for (int ai = 0; ai < 2; ++ai) {
#define EPI_HALF_END    asm volatile("" ::: "memory"); }
#define EPI_M_LOOP      _Pragma("unroll") for (int m = 0; m < 4; ++m) { const int row = row0 + ai * 128 + m * 16;
__device__ __forceinline__ u32x4 pack8(f32x4 v0, f32x4 v1) { u32x4 w; w.x = pk2(v0[0], v0[1]); w.y = pk2(v0[2], v0[3]); w.z = pk2(v1[0], v1[1]); w.w = pk2(v1[2], v1[3]); return w; }
__device__ __forceinline__ void unpack8(u32x4 w, f32x4& v0, f32x4& v1) { v0 = (f32x4){bflo(w.x), bfhi(w.x), bflo(w.y), bfhi(w.y)}; v1 = (f32x4){bflo(w.z), bfhi(w.z), bflo(w.w), bfhi(w.w)}; }
typedef f32x4 acc_t[2][2][4][2];
__device__ __forceinline__ void st8wt(void* p, u32x2 v) { asm volatile("global_store_dwordx2 %0, %1, off sc1" :: "v"(p), "v"(v) : "memory"); }
__device__ __forceinline__ void st16wt(void* p, u32x4 v) { asm volatile("global_store_dwordx4 %0, %1, off sc1\n\ts_nop 2" :: "v"(p), "v"(v) : "memory"); }

struct EpiIn {
    static constexpr bool HAS_PREP = false, FINAL = false, HAS_MID = false, HAS_INIT = false, HAS_A2 = false;
    bf16_t *H0, *HQK, *HVO, *HG; float* SSQ; float* G32;
    __device__ __forceinline__ void operator()(const acc_t& acc, const pg8::Unit& u, int wr, int wc, int fr, int fq, LAS unsigned char* tab) const {
        bf16_t* base; int ld, ct; const int pn = u.pn;
        if (pn < 3) { base = H0; ld = 768; ct = pn * 256; }
        else if (pn < 7) { base = HQK; ld = 1024; ct = (pn - 3) * 256; }
        else if (pn < 11) { base = HVO; ld = 1024; ct = (pn - 7) * 256; }
        else { base = HG; ld = 2048; ct = (pn - 11) * 256; }
        const int row0 = u.pm * 256 + wr * 64 + fr, col0 = ct + wc * 32 + 8 * fq;
        EPI_ROWS_BEGIN
            bf16_t* rp = base + (size_t)row * ld + col0;
#pragma unroll
            for (int bj = 0; bj < 2; ++bj) {
                const f32x4 v0 = acc[ai][bj][m][0], v1 = acc[ai][bj][m][1];
                *(u32x4*)(rp + bj * 128) = pack8(v0, v1);
                if (pn < 3) {
                    float s = dot4(v0) + dot4(v1); s += __shfl_xor(s, 16); s += __shfl_xor(s, 32);
                    if (fq == 0 && !(pn == 2 && bj == 1)) SSQ[(size_t)((pn * 2 + bj) * 4 + wc) * M + row] = s;
                    if (pn == 2 && bj == 1 && wc == 1 && fq < 2) { float* gp = G32 + (size_t)row * 16 + 8 * fq; *(f32x4*)gp = v0; *(f32x4*)(gp + 4) = v1; }
                }
            }
        EPI_ROWS_END
    }
};
struct EpiQ {
    static constexpr bool HAS_PREP = true, FINAL = false, HAS_MID = false, HAS_INIT = false, HAS_A2 = false;
    bf16_t* Q; const float* SSQ; const float* ROPE;
    __device__ __forceinline__ void prep(const pg8::Unit& u, LAS unsigned char* tab, int tid) const {
        if (tid < 256) { const int row = u.pm * 256 + tid; float ss = 0.f;
#pragma unroll
            for (int p = 0; p < 12; ++p) ss += SSQ[(size_t)p * M + row];
            ((LAS float*)tab)[tid] = rsqrtf(ss * (1.f / 384.f) + NORM_EPS) * (0.10206207261596575f * 1.4426950408889634f); }
    }
    __device__ __forceinline__ void operator()(const acc_t& acc, const pg8::Unit& u, int wr, int wc, int fr, int fq, LAS unsigned char* tab) const {
        const int row0 = u.pm * 256 + wr * 64 + fr, col0 = u.pn * 256 + wc * 32 + 8 * fq;
        EPI_HALF_BEGIN
            f32x4 rc[4][2], rs[4][2];
            EPI_M_LOOP
#pragma unroll
                for (int bj = 0; bj < 2; ++bj) { const int d = (col0 + bj * 128) % 96; rc[m][bj] = f32x4{}; rs[m][bj] = f32x4{};
                    if (d >= 64) { const int j0 = (d - 64) >> 1; rc[m][bj] = *(const f32x4*)(ROPE + (size_t)row * 32 + j0); rs[m][bj] = *(const f32x4*)(ROPE + (size_t)row * 32 + 16 + j0); } } }
            EPI_M_LOOP
                const float rstd = ((const LAS float*)tab)[row - u.pm * 256];
#pragma unroll
                for (int bj = 0; bj < 2; ++bj) {
                    const int col = col0 + bj * 128, d = col % 96;
                    f32x4 v0 = acc[ai][bj][m][0] * rstd, v1 = acc[ai][bj][m][1] * rstd;
                    if (d >= 64) { const f32x4 c = rc[m][bj], s = rs[m][bj]; const f32x4 o0 = v0 * c - v1 * s, o1 = v1 * c + v0 * s; v0 = o0; v1 = o1; }
                    *(u32x4*)(Q + (size_t)row * 768 + col) = pack8(v0, v1);
                } }
        EPI_HALF_END
    }
};
struct EpiKV {
    static constexpr bool HAS_PREP = true, FINAL = false, HAS_MID = false, HAS_INIT = false, HAS_A2 = false;
    bf16_t* KV; const float* SSQ;
    __device__ __forceinline__ void prep(const pg8::Unit& u, LAS unsigned char* tab, int tid) const {
        if (tid < 256) { const int row = u.pm * 256 + tid; float ss = 0.f;
#pragma unroll
            for (int p = 12; p < 20; ++p) ss += SSQ[(size_t)p * M + row];
            ((LAS float*)tab)[tid] = rsqrtf(ss * (1.f / 256.f) + NORM_EPS); }
    }
    __device__ __forceinline__ void operator()(const acc_t& acc, const pg8::Unit& u, int wr, int wc, int fr, int fq, LAS unsigned char* tab) const {
        const int row0 = u.pm * 256 + wr * 64 + fr, col0 = u.pn * 256 + wc * 32 + 8 * fq;
        EPI_ROWS_BEGIN
            const float rstd = ((const LAS float*)tab)[row - u.pm * 256];
#pragma unroll
            for (int bj = 0; bj < 2; ++bj) {
                const int col = col0 + bj * 128;
                *(u32x4*)(KV + (size_t)row * 1024 + col) = pack8(acc[ai][bj][m][0] * rstd, acc[ai][bj][m][1] * rstd);
            }
        EPI_ROWS_END
    }
};
struct EpiMergeF {
    static constexpr bool HAS_PREP = false, FINAL = false, HAS_MID = true, HAS_INIT = false, HAS_A2 = true;
    bf16_t* MG; const bf16_t* HG; size_t a2delta;
    __device__ __forceinline__ void mid(acc_t& acc, const pg8::Unit& u, int wr, int wc, int fr, int fq) const {
        int lane_ = threadIdx.x & 63; asm volatile("" : "+v"(lane_));
        const int row0 = u.pm * 256 + wr * 64 + (lane_ & 15), col0 = u.pn * 256 + wc * 32 + 8 * (lane_ >> 4);
#pragma unroll
        for (int ai = 0; ai < 2; ++ai)
#pragma unroll
            for (int mp = 0; mp < 2; ++mp) {
                u32x4 ga[2][2], gb[2][2];
#pragma unroll
                for (int mm = 0; mm < 2; ++mm) { const int row = row0 + ai * 128 + (2 * mp + mm) * 16;
#pragma unroll
                    for (int bj = 0; bj < 2; ++bj) { ga[mm][bj] = __builtin_nontemporal_load((const u32x4*)(HG + (size_t)row * 2048 + col0 + bj * 128)); gb[mm][bj] = *(const u32x4*)(HG + (size_t)row * 2048 + 1024 + col0 + bj * 128); } }
#pragma unroll
                for (int mm = 0; mm < 2; ++mm) { const int m = 2 * mp + mm;
#pragma unroll
                    for (int bj = 0; bj < 2; ++bj) { f32x4 a0, a1, b0, b1; unpack8(ga[mm][bj], a0, a1); unpack8(gb[mm][bj], b0, b1);
#pragma unroll
                        for (int e = 0; e < 4; ++e) {
                            acc[ai][bj][m][0][e] *= (1.f + __expf(fminf(-b0[e], 60.f))) * __builtin_amdgcn_rcpf(1.f + __expf(fminf(-a0[e], 60.f)));
                            acc[ai][bj][m][1][e] *= (1.f + __expf(fminf(-b1[e], 60.f))) * __builtin_amdgcn_rcpf(1.f + __expf(fminf(-a1[e], 60.f))); } } }
                asm volatile("" ::: "memory");
            }
    }
    __device__ __forceinline__ void operator()(const acc_t& acc, const pg8::Unit& u, int wr, int wc, int fr, int fq, LAS unsigned char* tab) const {
        const int row0 = u.pm * 256 + wr * 64 + fr, col0 = u.pn * 256 + wc * 32 + 8 * fq;
        EPI_HALF_BEGIN
            u32x4 gb[4][2];
            EPI_M_LOOP
#pragma unroll
                for (int bj = 0; bj < 2; ++bj) gb[m][bj] = __builtin_nontemporal_load((const u32x4*)(HG + (size_t)row * 2048 + 1024 + col0 + bj * 128)); }
            EPI_M_LOOP
#pragma unroll
                for (int bj = 0; bj < 2; ++bj) { f32x4 b0, b1; unpack8(gb[m][bj], b0, b1);
                    f32x4 v0 = acc[ai][bj][m][0], v1 = acc[ai][bj][m][1];
#pragma unroll
                    for (int e = 0; e < 4; ++e) { v0[e] *= __builtin_amdgcn_rcpf(1.f + __expf(fminf(-b0[e], 60.f))); v1[e] *= __builtin_amdgcn_rcpf(1.f + __expf(fminf(-b1[e], 60.f))); }
                    *(u32x4*)(MG + (size_t)row * 1024 + col0 + bj * 128) = pack8(v0, v1);
                } }
        EPI_HALF_END
    }
};
struct EpiRes {
    static constexpr bool HAS_PREP = false, FINAL = false, HAS_MID = false, HAS_INIT = true, HAS_A2 = false;
    const float* X; float* Y; bf16_t* YB; float* SSQ; bool early;
    __device__ __forceinline__ void init(acc_t& acc, const pg8::Unit& u, int wr, int wc, int fr, int fq) const {
        if (!early) return;
        int lane_ = threadIdx.x & 63; asm volatile("" : "+v"(lane_));
        const int row0 = u.pm * 256 + wr * 64 + (lane_ & 15), col0 = u.pn * 256 + wc * 32 + 8 * (lane_ >> 4);
#pragma unroll
        for (int ai = 0; ai < 2; ++ai)
#pragma unroll
            for (int m = 0; m < 4; ++m) { const int row = row0 + ai * 128 + m * 16;
#pragma unroll
                for (int bj = 0; bj < 2; ++bj) { const size_t off = (size_t)row * 1024 + col0 + bj * 128;
                    acc[ai][bj][m][0] = __builtin_nontemporal_load((const f32x4*)(X + off)); acc[ai][bj][m][1] = __builtin_nontemporal_load((const f32x4*)(X + off + 4)); } }
    }
    __device__ __forceinline__ void operator()(const acc_t& acc, const pg8::Unit& u, int wr, int wc, int fr, int fq, LAS unsigned char* tab) const {
        const int row0 = u.pm * 256 + wr * 64 + fr, col0 = u.pn * 256 + wc * 32 + 8 * fq;
        EPI_HALF_BEGIN
            f32x4 xa[4][2][2];
            EPI_M_LOOP
#pragma unroll
                for (int bj = 0; bj < 2; ++bj) { const size_t off = (size_t)row * 1024 + col0 + bj * 128; xa[m][bj][0] = f32x4{}; xa[m][bj][1] = f32x4{};
                    if (!early) { xa[m][bj][0] = __builtin_nontemporal_load((const f32x4*)(X + off)); xa[m][bj][1] = __builtin_nontemporal_load((const f32x4*)(X + off + 4)); } } }
            EPI_M_LOOP
                float s = 0.f;
#pragma unroll
                for (int bj = 0; bj < 2; ++bj) {
                    const size_t off = (size_t)row * 1024 + col0 + bj * 128;
                    const f32x4 v0 = xa[m][bj][0] + acc[ai][bj][m][0], v1 = xa[m][bj][1] + acc[ai][bj][m][1];
                    if (Y) { *(f32x4*)(Y + off) = v0; *(f32x4*)(Y + off + 4) = v1; }
                    if (YB) *(u32x4*)(YB + off) = pack8(v0, v1);
                    s += dot4(v0) + dot4(v1);
                }
                s += __shfl_xor(s, 16); s += __shfl_xor(s, 32);
                if (fq == 0) SSQ[(size_t)(u.pn * 4 + wc) * M + row] = s; }
        EPI_HALF_END
    }
};
struct EpiUp {
    static constexpr bool HAS_PREP = true, FINAL = false, HAS_MID = false, HAS_INIT = false, HAS_A2 = false;
    bf16_t* ACT; const float* SSQ1;
    __device__ __forceinline__ void prep(const pg8::Unit& u, LAS unsigned char* tab, int tid) const {
        if (tid < 256) { const int row = u.pm * 256 + tid; float ss = 0.f;
#pragma unroll
            for (int p = 0; p < 16; ++p) ss += SSQ1[(size_t)p * M + row];
            ((LAS float*)tab)[tid] = rsqrtf(ss * (1.f / 1024.f) + NORM_EPS); }
    }
    __device__ __forceinline__ void operator()(const acc_t& acc, const pg8::Unit& u, int wr, int wc, int fr, int fq, LAS unsigned char* tab) const {
        const int row0 = u.pm * 256 + wr * 64 + fr, col0 = u.pn * 256 + wc * 32 + 8 * fq;
        EPI_ROWS_BEGIN
            const float rstd = ((const LAS float*)tab)[row - u.pm * 256];
#pragma unroll
            for (int bj = 0; bj < 2; ++bj) {
                f32x4 v0 = acc[ai][bj][m][0] * rstd, v1 = acc[ai][bj][m][1] * rstd;
#pragma unroll
                for (int e = 0; e < 4; ++e) { const float a = fmaxf(v0[e], 0.f), b = fmaxf(v1[e], 0.f); v0[e] = a * a; v1[e] = b * b; }
                st16wt(ACT + (size_t)row * DFF + col0 + bj * 128, pack8(v0, v1));
            }
        EPI_ROWS_END
    }
};

struct EpiFinal {
    static constexpr bool HAS_PREP = false, FINAL = true, HAS_MID = false, HAS_INIT = false, HAS_A2 = false;
    const bf16_t* XB; float* Y; const float* gfin; float* SLAB; unsigned* cnt;
    __device__ __forceinline__ void operator()(const acc_t&, const pg8::Unit&, int, int, int, int, LAS unsigned char*) const {}
    __device__ __forceinline__ void fused(acc_t& acc, const pg8::Unit& u, int wr, int wc, int fr, int fq, LAS unsigned char* tab, int tid) const {
        LAS float* PT = (LAS float*)tab;
        LAS float* RS = PT + 1024;
        const int row0 = u.pm * 256 + wr * 64 + fr, col0 = u.pn * 256 + wc * 32 + 8 * fq;
        EPI_HALF_BEGIN
            u32x4 xb[4][2];
            EPI_M_LOOP
#pragma unroll
                for (int bj = 0; bj < 2; ++bj) xb[m][bj] = __builtin_nontemporal_load((const u32x4*)(XB + (size_t)row * 1024 + col0 + bj * 128)); }
            EPI_M_LOOP
                float s = 0.f;
#pragma unroll
                for (int bj = 0; bj < 2; ++bj) {
                    { f32x4 x0, x1; unpack8(xb[m][bj], x0, x1); acc[ai][bj][m][0] += x0; acc[ai][bj][m][1] += x1; }
                    s += dot4(acc[ai][bj][m][0]) + dot4(acc[ai][bj][m][1]);
                }
                s += __shfl_xor(s, 16); s += __shfl_xor(s, 32);
                if (fq == 0) PT[(row - u.pm * 256) * 4 + wc] = s; }
        EPI_HALF_END
        asm volatile("s_waitcnt lgkmcnt(0)" ::: "memory"); __builtin_amdgcn_s_barrier(); asm volatile("" ::: "memory");
        if (tid < 256) { const f32x4 p = *(const LAS f32x4*)(PT + tid * 4);
            __hip_atomic_store(SLAB + (size_t)u.pn * M + u.pm * 256 + tid, (p[0] + p[1]) + (p[2] + p[3]), __ATOMIC_RELAXED, __HIP_MEMORY_SCOPE_AGENT); }
        asm volatile("s_waitcnt vmcnt(0)" ::: "memory"); __builtin_amdgcn_s_barrier(); asm volatile("" ::: "memory");
        if (tid == 0) __hip_atomic_fetch_add(cnt + 64 * u.pm, 1u, __ATOMIC_RELAXED, __HIP_MEMORY_SCOPE_AGENT);
        if (tid < 64) { unsigned spins = 0;
            while (__hip_atomic_load(cnt + 64 * u.pm, __ATOMIC_RELAXED, __HIP_MEMORY_SCOPE_AGENT) < 4u) { __builtin_amdgcn_s_sleep(2); if (++spins > (1u << 20)) break; }
            __builtin_amdgcn_fence(__ATOMIC_ACQUIRE, "agent"); asm volatile("s_waitcnt vmcnt(0)" ::: "memory"); }
        __builtin_amdgcn_s_barrier(); asm volatile("" ::: "memory");
        if (tid < 256) { float ss = 0.f;
#pragma unroll
            for (int t = 0; t < 4; ++t) ss += __hip_atomic_load(SLAB + (size_t)t * M + u.pm * 256 + tid, __ATOMIC_RELAXED, __HIP_MEMORY_SCOPE_AGENT);
            RS[tid] = rsqrtf(ss * (1.f / 1024.f) + NORM_EPS); }
        asm volatile("s_waitcnt lgkmcnt(0)" ::: "memory"); __builtin_amdgcn_s_barrier(); asm volatile("" ::: "memory");
        f32x4 gf[2][2];
#pragma unroll
        for (int bj = 0; bj < 2; ++bj) { gf[bj][0] = *(const f32x4*)(gfin + col0 + bj * 128); gf[bj][1] = *(const f32x4*)(gfin + col0 + bj * 128 + 4); }
        EPI_ROWS_BEGIN
            const float rstd = RS[row - u.pm * 256];
#pragma unroll
            for (int bj = 0; bj < 2; ++bj) {
                const size_t off = (size_t)row * 1024 + col0 + bj * 128;
                *(f32x4*)(Y + off) = acc[ai][bj][m][0] * rstd * gf[bj][0]; *(f32x4*)(Y + off + 4) = acc[ai][bj][m][1] * rstd * gf[bj][1];
            }
        EPI_ROWS_END
    }
};

namespace att {
constexpr int NW = 8, QBLK = 32, KVBLK = 64;
constexpr float QSCALE = 0.10206207261596575f * 1.4426950408889634f;
constexpr float THRL = 8.f;
constexpr int LDQ = 768, LDKV = 1024, LDKR = 32, LDO = 1024;
constexpr int SLOTB = 12288, LDS_K = 0, LDS_V = 3 * SLOTB, SHM_ATTN = 6 * SLOTB;
#define SBAR() __builtin_amdgcn_sched_barrier(0)
#define WAIT_BAR(N) asm volatile("s_waitcnt vmcnt(" #N ") lgkmcnt(0)\n\ts_barrier" ::: "memory")
__device__ __forceinline__ void glds16(const void* gsrc, unsigned lds_dst) { unsigned keep;
  asm volatile("s_mov_b32 %0, m0\n\ts_mov_b32 m0, %2\n\ts_nop 0\n\tglobal_load_lds_dwordx4 %1, off\n\ts_mov_b32 m0, %0" : "=&s"(keep) : "v"(gsrc), "s"(lds_dst) : "memory"); }
typedef LAS const char* lds_cptr;
typedef short v4i16_t __attribute__((ext_vector_type(4)));
__device__ __forceinline__ void kload2(bf16x8* kf, lds_cptr kp, int j) { kf[2 * j] = *(const LAS bf16x8*)(kp + j * 2048); kf[2 * j + 1] = *(const LAS bf16x8*)(kp + j * 2048 + 512); }
__device__ __forceinline__ s16x4 vtr(lds_cptr p) { return __builtin_bit_cast(s16x4, __builtin_amdgcn_ds_read_tr16_b64_v4i16((LAS v4i16_t*)p)); }
__device__ __forceinline__ unsigned cvtpk_s(float lo, float hi) { typedef float f2_t __attribute__((ext_vector_type(2))); typedef __bf16 b2_t __attribute__((ext_vector_type(2)));
  f2_t v = {lo, hi}; b2_t b = __builtin_convertvector(v, b2_t); return __builtin_bit_cast(unsigned, b); }
#define MX3(a, b, c) __builtin_fmaxf(__builtin_fmaxf((a), (b)), (c))
__device__ __forceinline__ float rowmax(const f32x16& p0, const f32x16& p1) {
  float a = MX3(p0[0], p0[1], p1[0]), b = MX3(p0[2], p0[3], p1[1]); a = MX3(a, p1[2], p1[3]);
#pragma unroll
  for (int r = 4; r < 16; r += 4) { a = MX3(a, p0[r], p0[r + 1]); b = MX3(b, p0[r + 2], p0[r + 3]); a = MX3(a, p1[r], p1[r + 1]); b = MX3(b, p1[r + 2], p1[r + 3]); }
  float m = __builtin_fmaxf(a, b); auto rr = __builtin_amdgcn_permlane32_swap(__float_as_uint(m), __float_as_uint(m), false, false);
  return __builtin_fmaxf(__uint_as_float(rr[0]), __uint_as_float(rr[1])); }
#define MFMA(a, b, c) __builtin_amdgcn_mfma_f32_32x32x16_bf16(a, b, c, 0, 0, 0)
__device__ __forceinline__ void attn_unit(const bf16_t* __restrict__ Qb, const bf16_t* __restrict__ Kh, const bf16_t* __restrict__ KRb, bf16_t* __restrict__ Ob, LAS unsigned char* shm) {
  int tid = threadIdx.x; asm volatile("" : "+v"(tid));
  const int lane = tid & 63, r32 = lane & 31, hi = lane >> 5; const int wid = __builtin_amdgcn_readfirstlane(tid >> 6);
  const bool w3 = wid < 4;
  const unsigned lds0 = (unsigned)(uintptr_t)shm;
  const bf16_t* ksrc = Kh + (long)lane * LDKV + wid * 8;
  const bf16_t* rsrc = KRb + (long)lane * LDKR + (wid & 3) * 8;
  const bf16_t* vsrc = Kh + 64 + (long)(16 * (wid & 3) + (lane >> 2)) * LDKV + (wid >> 2) * 32 + (lane & 3) * 8;
  const unsigned kdst = lds0 + LDS_K + wid * 1024, rdst = lds0 + LDS_K + (8 + (wid & 3)) * 1024, vdst = lds0 + LDS_V + wid * 1024;
#define DMA_K(t, slot) do { glds16(ksrc + (long)(t) * KVBLK * LDKV, (unsigned)__builtin_amdgcn_readfirstlane(kdst + (slot))); \
    if (w3) glds16(rsrc + (long)(t) * KVBLK * LDKR, (unsigned)__builtin_amdgcn_readfirstlane(rdst + (slot))); } while (0)
#define DMA_V(t, slot) glds16(vsrc + (long)(t) * KVBLK * LDKV, (unsigned)__builtin_amdgcn_readfirstlane(vdst + (slot)))
#define WAITB(NHI, NLO) do { if (w3) { WAIT_BAR(NHI); } else { WAIT_BAR(NLO); } } while (0)
  const lds_cptr shm3 = (lds_cptr)shm; const lds_cptr kp0 = shm3 + LDS_K + hi * 1024 + r32 * 16;
  const lds_cptr vp0 = shm3 + LDS_V + ((lane >> 4) & 1) * 32 + (lane & 3) * 8 + (4 * hi + ((lane & 15) >> 2)) * 64;
  constexpr int NT = SEQ / KVBLK;
  DMA_K(0, 0); DMA_V(0, 0); DMA_K(1, SLOTB);
  bf16x8 qr[6]; bf16x8 kf[12];
  { const bf16_t* Qw = Qb + (long)(wid * QBLK + r32) * LDQ + hi * 8;
#pragma unroll
    for (int d0 = 0; d0 < 6; ++d0) qr[d0] = *reinterpret_cast<const bf16x8*>(Qw + d0 * 16); }
  float mhat = 0.f, l_reg = 0.f, fres = 1.f; f32x16 o[2]; o[0] = f32x16{}; o[1] = f32x16{}; f32x16 negm = f32x16{}; asm volatile("" : "+v"(negm));
  bool resc = false;
#define RESC() do { if (resc) { _Pragma("unroll") for (int d_ = 0; d_ < 2; ++d_) _Pragma("unroll") for (int r = 0; r < 16; ++r) o[d_][r] *= fres; } } while (0)
  f32x16 pA0, pA1, pB0, pB1;
  int sl_prev = 0, sl_cur = 0, sl_next = SLOTB;
#define ROT() do { sl_prev = sl_cur; sl_cur = sl_next; sl_next = (sl_next == 2 * SLOTB) ? 0 : sl_next + SLOTB; } while (0)
  DMA_K(2, 2 * SLOTB);
  WAITB(5, 3);
#pragma unroll
  for (int j = 0; j < 6; ++j) kload2(kf, kp0, j);
#pragma unroll
  for (int j = 0; j < 6; ++j) { pA0 = MFMA(kf[2 * j], qr[j], j ? pA0 : negm); pA1 = MFMA(kf[2 * j + 1], qr[j], j ? pA1 : negm); }
  { const float rm = rowmax(pA0, pA1); mhat = rm;
#pragma unroll
    for (int r = 0; r < 16; ++r) { pA0[r] = __builtin_amdgcn_exp2f(pA0[r] - rm); pA1[r] = __builtin_amdgcn_exp2f(pA1[r] - rm); }
#pragma unroll
    for (int r = 0; r < 16; ++r) negm[r] = -mhat;
    asm volatile("" : "+v"(negm)); }
  WAIT_BAR(0);
  DMA_K(3, 0); DMA_V(1, SLOTB);
  ROT();
#pragma unroll
  for (int j = 0; j < 6; ++j) kload2(kf, kp0 + sl_cur, j);
  WAITB(3, 2);
  s16x4 vlo[8], vhi[8]; u32x4 pw0, pw1, pw2, pw3;
#define PKW(P, B) cvtpk_s(P[B], P[(B) + 1])
#define PAF(k) __builtin_bit_cast(bf16x8, pw##k)
#define VFR(i) (bf16x8){vlo[i][0], vlo[i][1], vlo[i][2], vlo[i][3], vhi[i][0], vhi[i][1], vhi[i][2], vhi[i][3]}
#define PIN(x) asm volatile("" : "+v"(x))
#define EX(v) __builtin_amdgcn_exp2f(v)
#define VRD(i) do { vlo[i] = vtr(vp_ + (((i) >> 2) * 4096 + ((i) & 3) * 1024)); vhi[i] = vtr(vp_ + (((i) >> 2) * 4096 + ((i) & 3) * 1024 + 512)); } while (0)
#define KRD(G, j) do { if (G) { kload2(kf, kp0 + sl_next, j); SBAR(); } } while (0)
#define GA3(MF, A0, A1, A2, W0, PW) do { MF; sacc += A0; sacc += A1; sacc += A2; PIN(sacc); W0; PIN(PW); SBAR(); } while (0)
#define GA2(MF, A0, A1, W0, W1, PW) do { MF; sacc += A0; sacc += A1; PIN(sacc); W0; W1; PIN(PW); SBAR(); } while (0)
#define GA2S(MF, A0, A1, W0, PW) do { MF; sacc += A0; sacc += A1; PIN(sacc); W0; PIN(PW); SBAR(); } while (0)
#define GAPB(MF, X, B) do { MF; X[B] = EX(X[B]); X[(B) + 1] = EX(X[(B) + 1]); X[(B) + 2] = EX(X[(B) + 2]); X[(B) + 3] = EX(X[(B) + 3]); PIN(X); SBAR(); } while (0)
#define STEP(C0, C1, P0, P1, t, GK, GV, GL) do { SBAR(); \
    const lds_cptr vp_ = vp0 + sl_prev; \
    VRD(0); SBAR(); float sacc = (P0[0] + P0[1]); \
                    GA3(C0 = MFMA(kf[0], qr[0], negm),  P0[2], P0[3], P0[4],      pw0[0] = PKW(P0, 0), pw0); \
    VRD(4); SBAR(); GA3(C1 = MFMA(kf[1], qr[0], negm),  P0[5], P0[6], P0[7],      pw0[1] = PKW(P0, 2), pw0); \
                    GA2(C0 = MFMA(kf[2], qr[1], C0),    P0[8], P0[9],             pw0[2] = PKW(P0, 4), pw0[3] = PKW(P0, 6), pw0); \
    VRD(1); SBAR(); GA3(C1 = MFMA(kf[3], qr[1], C1),    P0[10], P0[11], P0[12],   pw1[0] = PKW(P0, 8), pw1); \
    VRD(5); SBAR(); GA3(C0 = MFMA(kf[4], qr[2], C0),    P0[13], P0[14], P0[15],   pw1[1] = PKW(P0, 10), pw1); \
                    GA2(C1 = MFMA(kf[5], qr[2], C1),    P1[0], P1[1],             pw1[2] = PKW(P0, 12), pw1[3] = PKW(P0, 14), pw1); \
    VRD(2); SBAR(); GA3(C0 = MFMA(kf[6], qr[3], C0),    P1[2], P1[3], P1[4],      pw2[0] = PKW(P1, 0), pw2); \
    VRD(6); SBAR(); GA3(C1 = MFMA(kf[7], qr[3], C1),    P1[5], P1[6], P1[7],      pw2[1] = PKW(P1, 2), pw2); \
                    GA2(C0 = MFMA(kf[8], qr[4], C0),    P1[8], P1[9],             pw2[2] = PKW(P1, 4), pw2[3] = PKW(P1, 6), pw2); \
    VRD(3); SBAR(); GA2S(C1 = MFMA(kf[9], qr[4], C1),   P1[10], P1[11],           pw3[0] = PKW(P1, 8), pw3); \
    VRD(7); SBAR(); GA2S(C0 = MFMA(kf[10], qr[5], C0),  P1[12], P1[13],           pw3[1] = PKW(P1, 10), pw3); \
                    GA2(C1 = MFMA(kf[11], qr[5], C1),   P1[14], P1[15],           pw3[2] = PKW(P1, 12), pw3[3] = PKW(P1, 14), pw3); \
    l_reg += sacc; \
    if (GK) { DMA_K((t) + 3, sl_cur); } if (GV) { DMA_V((t) + 1, sl_next); } \
    { const float rm = rowmax(C0, C1); resc = false; \
      if (__builtin_expect(__any(rm > THRL), 0)) { const float dl = __builtin_fmaxf(rm, 0.f); mhat += dl; \
        _Pragma("unroll") for (int r = 0; r < 16; ++r) { C0[r] -= dl; C1[r] -= dl; } \
        _Pragma("unroll") for (int r = 0; r < 16; ++r) negm[r] = -mhat; \
        asm volatile("" : "+v"(negm)); \
        fres = __builtin_amdgcn_exp2f(-dl); l_reg *= fres; resc = true; } } \
    SBAR(); \
                GAPB(o[0] = MFMA(VFR(0), PAF(0), o[0]), C0, 0); \
    KRD(GL, 0); GAPB(o[1] = MFMA(VFR(4), PAF(0), o[1]), C0, 4); \
    KRD(GL, 1); GAPB(o[0] = MFMA(VFR(1), PAF(1), o[0]), C0, 8); \
    KRD(GL, 2); GAPB(o[1] = MFMA(VFR(5), PAF(1), o[1]), C0, 12); \
    KRD(GL, 3); GAPB(o[0] = MFMA(VFR(2), PAF(2), o[0]), C1, 0); \
    KRD(GL, 4); GAPB(o[1] = MFMA(VFR(6), PAF(2), o[1]), C1, 4); \
    KRD(GL, 5); GAPB(o[0] = MFMA(VFR(3), PAF(3), o[0]), C1, 8); \
                GAPB(o[1] = MFMA(VFR(7), PAF(3), o[1]), C1, 12); \
    } while (0)
  int t = 1;
  for (; t + 5 < NT; t += 2) {
    STEP(pB0, pB1, pA0, pA1, t, true, true, true);     WAITB(3, 2); RESC(); ROT();
    STEP(pA0, pA1, pB0, pB1, t + 1, true, true, true); WAITB(3, 2); RESC(); ROT();
  }
#define ENDW(tt) do { if ((tt) + 3 < NT) { WAITB(3, 2); } else if ((tt) + 2 < NT) { WAIT_BAR(1); } else { WAIT_BAR(0); } } while (0)
  for (; t + 1 < NT; t += 2) {
    STEP(pB0, pB1, pA0, pA1, t, (t + 3 < NT), (t + 1 < NT), (t + 1 < NT));         ENDW(t);     RESC(); ROT();
    STEP(pA0, pA1, pB0, pB1, t + 1, (t + 4 < NT), (t + 2 < NT), (t + 2 < NT));     ENDW(t + 1); RESC(); ROT();
  }
  STEP(pB0, pB1, pA0, pA1, NT - 1, false, false, false); RESC();
  { float sacc = pB0[0] + pB0[1];
#pragma unroll
    for (int r = 2; r < 16; ++r) sacc += pB0[r];
#pragma unroll
    for (int r = 0; r < 16; ++r) sacc += pB1[r];
    l_reg += sacc;
    pw0 = (u32x4){PKW(pB0, 0), PKW(pB0, 2), PKW(pB0, 4), PKW(pB0, 6)}; pw1 = (u32x4){PKW(pB0, 8), PKW(pB0, 10), PKW(pB0, 12), PKW(pB0, 14)};
    pw2 = (u32x4){PKW(pB1, 0), PKW(pB1, 2), PKW(pB1, 4), PKW(pB1, 6)}; pw3 = (u32x4){PKW(pB1, 8), PKW(pB1, 10), PKW(pB1, 12), PKW(pB1, 14)};
    const lds_cptr vp_ = vp0 + sl_cur;
#pragma unroll
    for (int i = 0; i < 8; ++i) VRD(i);
    o[0] = MFMA(VFR(0), PAF(0), o[0]); o[1] = MFMA(VFR(4), PAF(0), o[1]); o[0] = MFMA(VFR(1), PAF(1), o[0]); o[1] = MFMA(VFR(5), PAF(1), o[1]);
    o[0] = MFMA(VFR(2), PAF(2), o[0]); o[1] = MFMA(VFR(6), PAF(2), o[1]); o[0] = MFMA(VFR(3), PAF(3), o[0]); o[1] = MFMA(VFR(7), PAF(3), o[1]); }
  { auto rr = __builtin_amdgcn_permlane32_swap(__float_as_uint(l_reg), __float_as_uint(l_reg), false, false); l_reg = __uint_as_float(rr[0]) + __uint_as_float(rr[1]); }
  const float rl = __builtin_amdgcn_rcpf(l_reg);
  bf16_t* Ow = Ob + (long)(wid * QBLK + r32) * LDO + 4 * hi;
#pragma unroll
  for (int d0 = 0; d0 < 2; ++d0)
#pragma unroll
    for (int i = 0; i < 4; ++i) { u32x2 w; w.x = pk2(o[d0][4 * i] * rl, o[d0][4 * i + 1] * rl); w.y = pk2(o[d0][4 * i + 2] * rl, o[d0][4 * i + 3] * rl); *(u32x2*)(Ow + d0 * 32 + 8 * i) = w; }
  asm volatile("s_waitcnt lgkmcnt(0)\n\ts_barrier" ::: "memory");
#undef DMA_K
#undef DMA_V
#undef WAITB
#undef RESC
#undef ROT
#undef PKW
#undef PAF
#undef VFR
#undef PIN
#undef EX
#undef VRD
#undef KRD
#undef GA3
#undef GA2
#undef GA2S
#undef GAPB
#undef STEP
#undef ENDW
}
#undef SBAR
#undef WAIT_BAR
#undef MX3
#undef MFMA
}

struct Ptrs {
    const float* x; const int* pos; const float *g_mix, *w_in, *g_q, *w_uq, *g_kv, *w_ukv, *conv_w, *conv_b, *ig_b, *fg_b, *g_on, *w_bm, *w_bl, *w_out, *g_mlp, *w_up, *w_dn, *g_fin;
    float* out; unsigned char* ws;
    bf16_t *WinT, *WuqT, *WukvT, *WbmT, *WblT, *WoutT, *WupT, *WdnT;
    float *ROPE, *SSQ, *SSQ1, *SSQ2, *G32, *UN, *BL, *ML, *MP;
    bf16_t *H0, *HQK, *HVO, *HG, *XN, *UC, *QC, *KC, *VTG, *G1, *MERGED, *X1B, *ACT, *YA, *YM, *Q, *KV, *KR;
};

__device__ __forceinline__ float logsig_(float x) { return fminf(x, 0.f) - log1pf(__expf(-fabsf(x))); }
__device__ __forceinline__ float wave_scan_add(float v, int lane) {
#pragma unroll
    for (int o = 1; o < 64; o <<= 1) { const float t = __shfl_up(v, o); if (lane >= o) v += t; }
    return v;
}
__device__ __forceinline__ float wave_scan_max(float v, int lane) {
#pragma unroll
    for (int o = 1; o < 64; o <<= 1) { const float t = __shfl_up(v, o); if (lane >= o) v = fmaxf(v, t); }
    return v;
}
__device__ __forceinline__ float wave_max(float v) {
#pragma unroll
    for (int o = 1; o < 64; o <<= 1) v = fmaxf(v, __shfl_xor(v, o));
    return v;
}
__device__ __forceinline__ f32x4 mfma16(bf16x8 a, bf16x8 b, f32x4 c) { return __builtin_amdgcn_mfma_f32_16x16x32_bf16(a, b, c, 0, 0, 0); }
__device__ __forceinline__ void conv_load(const bf16_t* __restrict__ HQK, long trow0, long seq_lo, long seq_hi, int ch, int tg, u32x4 (&xr)[6]) {
#pragma unroll
    for (int i = 0; i < 6; ++i) { const long r = trow0 + 2 * tg - 2 + i;
        const bool in = (r >= seq_lo && r < seq_hi); const long rc = in ? r : seq_lo; const u32x4 w = *(const u32x4*)(HQK + rc * 1024 + ch); const unsigned mk = in ? 0xffffffffu : 0u;
        xr[i] = (u32x4){w.x & mk, w.y & mk, w.z & mk, w.w & mk}; }
}
__device__ __forceinline__ void conv_compute(const u32x4 (&xr)[6], int ch, const float* __restrict__ cw, const float* __restrict__ cbias, float (&o0)[8], float (&o1)[8]) {
    asm volatile("" : "+v"(ch));
    const f32x4 b0 = *(const f32x4*)(cbias + ch), b1 = *(const f32x4*)(cbias + ch + 4);
#pragma unroll
    for (int e = 0; e < 8; ++e) { o0[e] = e < 4 ? b0[e & 3] : b1[e & 3]; o1[e] = o0[e]; }
#define XV(i, e) (((e) & 1) ? bfhi(xr[i][(e) >> 1]) : bflo(xr[i][(e) >> 1]))
#pragma unroll
    for (int j = 0; j < 5; ++j) { const f32x4 w0 = *(const f32x4*)(cw + j * 1024 + ch), w1 = *(const f32x4*)(cw + j * 1024 + ch + 4);
#pragma unroll
        for (int e = 0; e < 8; ++e) { const float w = e < 4 ? w0[e & 3] : w1[e & 3]; o0[e] += w * XV(j, e); o1[e] += w * XV(j + 1, e); } }
#undef XV
#pragma unroll
    for (int e = 0; e < 8; ++e) { o0[e] = o0[e] * sigmoidf_(o0[e]); o1[e] = o1[e] * sigmoidf_(o1[e]); }
}
__device__ __forceinline__ void vt_load(const bf16_t* __restrict__ HVO, long t0, int h, int tid, u32x4 (&w)[2]) {
    const int cc = (tid & 3) | (((tid >> 7) & 3) << 2), s = (tid >> 2) & 31;
#pragma unroll
    for (int half = 0; half < 2; ++half) w[half] = *(const u32x4*)(HVO + (t0 + s + 32 * half) * 1024 + h * 128 + 8 * cc);
}
__device__ __forceinline__ void vt_scatter(const u32x4 (&wv)[2], LAS bf16_t* VT, int tid) {
    const int cc = (tid & 3) | (((tid >> 7) & 3) << 2), s = (tid >> 2) & 31;
#pragma unroll
    for (int half = 0; half < 2; ++half) { const int ss = s + 32 * half; const u32x4 w = wv[half];
        LAS bf16_t* p = VT + (8 * cc) * 72 + ss;
        p[0 * 72] = (bf16_t)(w.x & 0xffffu); p[1 * 72] = (bf16_t)(w.x >> 16); p[2 * 72] = (bf16_t)(w.y & 0xffffu); p[3 * 72] = (bf16_t)(w.y >> 16);
        p[4 * 72] = (bf16_t)(w.z & 0xffffu); p[5 * 72] = (bf16_t)(w.z >> 16); p[6 * 72] = (bf16_t)(w.w & 0xffffu); p[7 * 72] = (bf16_t)(w.w >> 16); }
}
constexpr float KSCALE = 0.08838834764831845f;

constexpr int NCH = 32;
__device__ __forceinline__ f32x16 mfma32(bf16x8 a, bf16x8 b, f32x16 c) { return __builtin_amdgcn_mfma_f32_32x32x16_bf16(a, b, c, 0, 0, 0); }
__device__ __forceinline__ void mlstm_pass1_unit(const Ptrs& P, LAS unsigned char* lds, int b, int h, int c, int tid) {
    asm volatile("" : "+v"(tid));
    const int lane = tid & 63, wid = __builtin_amdgcn_readfirstlane(tid >> 6);
    LAS float* W = (LAS float*)lds;
    LAS float* SC = (LAS float*)(lds + 2048);
    LAS bf16_t* KTW = (LAS bf16_t*)(lds + 4096);
    LAS bf16_t* VT = (LAS bf16_t*)(lds + 4096 + 36864);
    const long t0 = (long)b * SEQ + 256 * c;
    { const int dir = tid >> 8, j = tid & 255, o = dir ? 255 - j : j; const long t = t0 + o; const int base = wid & 4, w4 = wid & 3;
      const float f = P.G32[t * 16 + dir * 8 + 4 + h] + P.fg_b[dir * 4 + h], ig = P.G32[t * 16 + dir * 8 + h] + P.ig_b[dir * 4 + h];
      const float incl = wave_scan_add(logsig_(f), lane); if (lane == 63) SC[wid] = incl;
      __syncthreads();
      const float off = (w4 > 0 ? SC[base] : 0.f) + (w4 > 1 ? SC[base + 1] : 0.f) + (w4 > 2 ? SC[base + 2] : 0.f);
      const float bl = (SC[base] + SC[base + 1]) + (SC[base + 2] + SC[base + 3]);
      const float we = bl - (incl + off) + ig, wm = wave_max(we); if (lane == 0) SC[8 + wid] = wm;
      __syncthreads();
      const float mloc = fmaxf(fmaxf(SC[8 + base], SC[8 + base + 1]), fmaxf(SC[8 + base + 2], SC[8 + base + 3]));
      W[dir * 256 + o] = __expf(we - mloc);
      if (j == 0) { const int chain = (dir * 2 + b) * 4 + h, cd = dir ? NCH - 1 - c : c; P.BL[chain * NCH + cd] = bl; P.ML[chain * NCH + cd] = mloc; }
    }
    __syncthreads();
    const int dirw = wid >> 2, mb = wid & 3, l15 = lane & 15, lq = lane >> 4;
    f32x4 acc[2][8];
#pragma unroll
    for (int mt = 0; mt < 2; ++mt)
#pragma unroll
        for (int nt = 0; nt < 8; ++nt) acc[mt][nt] = (f32x4){0.f, 0.f, 0.f, 0.f};
    float unacc = 0.f;
#pragma unroll 1
    for (int sub = 0; sub < 4; ++sub) {
        const long ts = t0 + 64 * sub;
        int tl = tid; asm volatile("" : "+v"(tl));
        const int ll15 = tl & 15, llq = (tl & 63) >> 4;
        { const int tg = (tl >> 2) & 31, cc = (tl & 3) | (((tl >> 7) & 3) << 2); float k0[8], k1[8];
          u32x4 xq[6], xk[6], wv[2];
          conv_load(P.HQK, ts, (long)b * SEQ, (long)(b + 1) * SEQ, h * 128 + 8 * cc, tg, xq);
          conv_compute(xq, h * 128 + 8 * cc, P.conv_w, P.conv_b, k0, k1);
          { u32x4 w0, w1; w0.x = pk2(k0[0], k0[1]); w0.y = pk2(k0[2], k0[3]); w0.z = pk2(k0[4], k0[5]); w0.w = pk2(k0[6], k0[7]);
            w1.x = pk2(k1[0], k1[1]); w1.y = pk2(k1[2], k1[3]); w1.z = pk2(k1[4], k1[5]); w1.w = pk2(k1[6], k1[7]);
            *(u32x4*)(P.QC + (ts + 2 * tg) * 512 + h * 128 + 8 * cc) = w0; *(u32x4*)(P.QC + (ts + 2 * tg + 1) * 512 + h * 128 + 8 * cc) = w1; }
          asm volatile("" ::: "memory");
          conv_load(P.HQK, ts, (long)b * SEQ, (long)(b + 1) * SEQ, 512 + h * 128 + 8 * cc, tg, xk);
          vt_load(P.HVO, ts, h, tl, wv);
          conv_compute(xk, 512 + h * 128 + 8 * cc, P.conv_w, P.conv_b, k0, k1);
#pragma unroll
          for (int e = 0; e < 8; ++e) { k0[e] *= KSCALE; k1[e] *= KSCALE; }
          { u32x4 w0, w1; w0.x = pk2(k0[0], k0[1]); w0.y = pk2(k0[2], k0[3]); w0.z = pk2(k0[4], k0[5]); w0.w = pk2(k0[6], k0[7]);
            w1.x = pk2(k1[0], k1[1]); w1.y = pk2(k1[2], k1[3]); w1.z = pk2(k1[4], k1[5]); w1.w = pk2(k1[6], k1[7]);
            *(u32x4*)(P.KC + (ts + 2 * tg) * 512 + h * 128 + 8 * cc) = w0; *(u32x4*)(P.KC + (ts + 2 * tg + 1) * 512 + h * 128 + 8 * cc) = w1; }
          const int ow = 64 * sub + 2 * tg;
          const float wf0 = W[ow], wf1 = W[ow + 1], wb0 = W[256 + ow], wb1 = W[256 + ow + 1];
#pragma unroll
          for (int e = 0; e < 8; ++e) { const int dk = 8 * cc + e;
              *(LAS unsigned*)(KTW + dk * 72 + 2 * tg) = pk2(wf0 * k0[e], wf1 * k1[e]);
              *(LAS unsigned*)(KTW + (128 + dk) * 72 + 2 * tg) = pk2(wb0 * k0[e], wb1 * k1[e]); }
          vt_scatter(wv, VT, tl); }
        __syncthreads();
        { bf16x8 X[2][2];
#pragma unroll
          for (int mt = 0; mt < 2; ++mt)
#pragma unroll
              for (int ks = 0; ks < 2; ++ks) X[mt][ks] = *(const LAS bf16x8*)(KTW + (dirw * 128 + mb * 32 + mt * 16 + ll15) * 72 + ks * 32 + llq * 8);
#pragma unroll
          for (int nt = 0; nt < 8; ++nt)
#pragma unroll
              for (int ks = 0; ks < 2; ++ks) { const bf16x8 Y = *(const LAS bf16x8*)(VT + (nt * 16 + ll15) * 72 + ks * 32 + llq * 8);
#pragma unroll
                  for (int mt = 0; mt < 2; ++mt) acc[mt][nt] = mfma16(X[mt][ks], Y, acc[mt][nt]); } }
        { const int d2 = tl >> 8, dk = (tl >> 1) & 127, hf = tl & 1;
#pragma unroll 8
          for (int i = 0; i < 32; ++i) unacc += bf2f(KTW[(d2 * 128 + dk) * 72 + hf * 32 + i]); }
#pragma unroll
        for (int i = 0; i < 2; ++i) { const int idx = tl + 512 * i, dv = idx >> 3, ch = idx & 7;
            *(u32x4*)(P.VTG + ((size_t)((b * 4 + h) * 128 + dv)) * SEQ + 256 * c + 64 * sub + 8 * ch) = *(const LAS u32x4*)(VT + dv * 72 + 8 * ch); }
        __syncthreads();
    }
    { const int chain = (dirw * 2 + b) * 4 + h, cd = dirw ? NCH - 1 - c : c;
      bf16_t* Ub = P.UC + (size_t)(chain * NCH + cd) * 16384;
#pragma unroll
      for (int mt = 0; mt < 2; ++mt)
#pragma unroll
          for (int nt = 0; nt < 8; ++nt) { const int dv = nt * 16 + l15, dk = mb * 32 + mt * 16 + 4 * lq; u32x2 w; w.x = pk2(acc[mt][nt][0], acc[mt][nt][1]); w.y = pk2(acc[mt][nt][2], acc[mt][nt][3]);
              *(u32x2*)(Ub + dv * 128 + dk) = w; } }
    { const int d2 = tid >> 8, dk = (tid >> 1) & 127, hf = tid & 1;
      unacc += __shfl_xor(unacc, 1);
      const int chain = (d2 * 2 + b) * 4 + h, cd = d2 ? NCH - 1 - c : c;
      if (hf == 0) P.UN[(size_t)(chain * NCH + cd) * 128 + dk] = unacc; }
    __syncthreads();
}
__device__ __forceinline__ void mlstm_pass2(const Ptrs& P, LAS unsigned char* lds, int vcu, int G, int tid) {
    LAS float* DEC = (LAS float*)lds; LAS float* BET = DEC + 512; LAS float* LBL = DEC + 1024; LAS float* LML = DEC + 1536;
    if (G == 256) {
        const int x = vcu >> 5, r = vcu & 31, bb = x >> 2, hh = x & 3;
        if (tid < 2 * NCH) { const int chain = ((tid >> 5) * 2 + bb) * 4 + hh; LBL[tid] = P.BL[chain * NCH + (tid & 31)]; LML[tid] = P.ML[chain * NCH + (tid & 31)]; }
        __syncthreads();
        if (tid < 2) { const int chain = (tid * 2 + bb) * 4 + hh; float m = 0.f;
            for (int c = 0; c < NCH; ++c) { const float bl = LBL[tid * NCH + c], ml = LML[tid * NCH + c]; if (r == 0) P.MP[chain * NCH + c] = m;
                const float mn = fmaxf(bl + m, ml); DEC[tid * NCH + c] = __expf(bl + m - mn); BET[tid * NCH + c] = __expf(ml - mn); m = mn; } }
        __syncthreads();
        { const int li = r * 512 + tid, dir = li >> 13, e2 = li & 8191, chain = (dir * 2 + bb) * 4 + hh;
          unsigned* p = (unsigned*)P.UC + (size_t)chain * NCH * 8192 + e2; float s0 = 0.f, s1 = 0.f;
          for (int c0 = 0; c0 < NCH; c0 += 8) { unsigned u[8];
#pragma unroll
              for (int k = 0; k < 8; ++k) u[k] = p[(size_t)(c0 + k) * 8192];
#pragma unroll
              for (int k = 0; k < 8; ++k) { const float d = DEC[dir * NCH + c0 + k], bt = BET[dir * NCH + c0 + k]; p[(size_t)(c0 + k) * 8192] = pk2(s0, s1);
                  s0 = d * s0 + bt * bflo(u[k]); s1 = d * s1 + bt * bfhi(u[k]); } } }
        if (r == 0 && tid < 256) { const int dir = tid >> 7, dk = tid & 127, chain = (dir * 2 + bb) * 4 + hh; float* p = P.UN + (size_t)chain * NCH * 128 + dk; float s = 0.f;
            for (int c = 0; c < NCH; ++c) { const float u = p[c * 128]; p[c * 128] = s; s = DEC[dir * NCH + c] * s + BET[dir * NCH + c] * u; } }
        __syncthreads();
        return;
    }
    if (tid < 16 * NCH) { LBL[tid] = P.BL[tid]; LML[tid] = P.ML[tid]; }
    __syncthreads();
    if (tid < 16) { const int chain = tid; float m = 0.f;
        for (int c = 0; c < NCH; ++c) { const float bl = LBL[chain * NCH + c], ml = LML[chain * NCH + c]; if (vcu == 0) P.MP[chain * NCH + c] = m;
            const float mn = fmaxf(bl + m, ml); DEC[chain * NCH + c] = __expf(bl + m - mn); BET[chain * NCH + c] = __expf(ml - mn); m = mn; } }
    __syncthreads();
    unsigned* UCw = (unsigned*)P.UC;
    for (int w = vcu * 512 + tid; w < 16 * 8192; w += G * 512) { const int chain = w >> 13, e2 = w & 8191; unsigned* p = UCw + (size_t)chain * NCH * 8192 + e2; float s0 = 0.f, s1 = 0.f;
        for (int c0 = 0; c0 < NCH; c0 += 8) { unsigned u[8];
#pragma unroll
            for (int k = 0; k < 8; ++k) u[k] = p[(size_t)(c0 + k) * 8192];
#pragma unroll
            for (int k = 0; k < 8; ++k) { const float d = DEC[chain * NCH + c0 + k], bt = BET[chain * NCH + c0 + k]; p[(size_t)(c0 + k) * 8192] = pk2(s0, s1);
                s0 = d * s0 + bt * bflo(u[k]); s1 = d * s1 + bt * bfhi(u[k]); } } }
    for (int w = vcu * 512 + tid; w < 2048; w += G * 512) { const int chain = w >> 7, dk = w & 127; float* p = P.UN + (size_t)chain * NCH * 128 + dk; float s = 0.f;
        for (int c = 0; c < NCH; ++c) { const float u = p[c * 128]; p[c * 128] = s; s = DEC[chain * NCH + c] * s + BET[chain * NCH + c] * u; } }
    __syncthreads();
}
__device__ __forceinline__ void mlstm_pass3_unit(const Ptrs& P, LAS unsigned char* lds, int b, int h, int c, int tid) {
    asm volatile("" : "+v"(tid));
    const int lane = tid & 63, wid = __builtin_amdgcn_readfirstlane(tid >> 6), l31 = lane & 31, hi = lane >> 5;
    LAS bf16_t* KS = (LAS bf16_t*)lds;
    LAS bf16_t* VT = (LAS bf16_t*)(lds + 69632);
    LAS float* PA = (LAS float*)(lds + 137216);
    LAS float* PMU = PA + 512; LAS float* PIW = PA + 1024; LAS float* PFL = PA + 1536; LAS float* SC = PA + 2048;
    const long t0 = (long)b * SEQ + 256 * c;
    u32x4 stg[16];
#pragma unroll
    for (int i = 0; i < 8; ++i) { const int idx = tid + 512 * i, row = idx >> 4, ch = idx & 15; stg[i] = *(const u32x4*)(P.KC + (t0 + row) * 512 + h * 128 + 8 * ch); }
#pragma unroll
    for (int i = 0; i < 8; ++i) { const int idx = tid + 512 * i, dv = idx >> 5, ch = idx & 31; stg[8 + i] = *(const u32x4*)(P.VTG + ((size_t)((b * 4 + h) * 128 + dv)) * SEQ + 256 * c + 8 * ch); }
    const int o1 = 32 * wid + l31;
    bf16x8 qf[8];
    { const bf16_t* qp = P.QC + (t0 + o1) * 512 + h * 128 + 8 * hi;
#pragma unroll
      for (int s = 0; s < 8; ++s) qf[s] = *(const bf16x8*)(qp + 16 * s); }
    { const int dir = tid >> 8, j = tid & 255, o = dir ? 255 - j : j; const long t = t0 + o; const int base = wid & 4, w4 = wid & 3;
      const int chain = (dir * 2 + b) * 4 + h, cd = dir ? NCH - 1 - c : c;
      const float f = P.G32[t * 16 + dir * 8 + 4 + h] + P.fg_b[dir * 4 + h], ig = P.G32[t * 16 + dir * 8 + h] + P.ig_b[dir * 4 + h];
      const float incl = wave_scan_add(logsig_(f), lane); if (lane == 63) SC[wid] = incl;
      __syncthreads();
      const float off = (w4 > 0 ? SC[base] : 0.f) + (w4 > 1 ? SC[base + 1] : 0.f) + (w4 > 2 ? SC[base + 2] : 0.f);
      const float bs = incl + off, a = ig - bs, imax = wave_scan_max(a, lane); if (lane == 63) SC[8 + wid] = imax;
      __syncthreads();
      float pm = -__builtin_inff(); if (w4 > 0) pm = SC[8 + base]; if (w4 > 1) pm = fmaxf(pm, SC[8 + base + 1]); if (w4 > 2) pm = fmaxf(pm, SC[8 + base + 2]);
      const float mp = P.MP[chain * NCH + cd], mu = fmaxf(mp, fmaxf(imax, pm));
      PA[dir * 256 + o] = a; PMU[dir * 256 + o] = mu; PIW[dir * 256 + o] = __expf(mp - mu); PFL[dir * 256 + o] = __expf(-(bs + mu)); }
#pragma unroll
    for (int i = 0; i < 8; ++i) { const int idx = tid + 512 * i, row = idx >> 4, ch = idx & 15; *(LAS u32x4*)(KS + row * 136 + 8 * ch) = stg[i]; }
#pragma unroll
    for (int i = 0; i < 8; ++i) { const int idx = tid + 512 * i, dv = idx >> 5, ch = idx & 31; *(LAS u32x4*)(VT + dv * 264 + 8 * ch) = stg[8 + i]; }
    __syncthreads();
    f32x16 hs[4];
#pragma unroll
    for (int dir = 0; dir < 2; ++dir) {
        const int chain = (dir * 2 + b) * 4 + h, cd = dir ? NCH - 1 - c : c;
        const float mu1 = PMU[dir * 256 + o1], iw1 = PIW[dir * 256 + o1], fl1 = PFL[dir * 256 + o1];
        f32x16 acc[4];
#define CLD4(dst, D, S0) do { int ll_ = lane; asm volatile("" : "+v"(ll_)); const bf16_t* cp_ = P.UC + (size_t)(chain * NCH + cd) * 16384 + (32 * (D) + (ll_ & 31)) * 128 + 8 * (ll_ >> 5) + 16 * (S0); \
            _Pragma("unroll") for (int s_ = 0; s_ < 4; ++s_) dst[s_] = *(const bf16x8*)(cp_ + 16 * s_); } while (0)
#define MM4(D, src, S0) do { _Pragma("unroll") for (int s_ = 0; s_ < 4; ++s_) acc[D] = mfma32(src[s_], qf[(S0) + s_], acc[D]); } while (0)
        if (dir == 0) {
            bf16x8 ca[4], cb[4], cc[4];
            CLD4(ca, 0, 0); CLD4(cb, 0, 4);
#pragma unroll
            for (int d = 0; d < 4; ++d) { acc[d] = f32x16{};
                if (d < 3) CLD4(cc, d + 1, 0);
                __builtin_amdgcn_sched_barrier(0); MM4(d, ca, 0); __builtin_amdgcn_sched_barrier(0);
                if (d < 3) CLD4(ca, d + 1, 4);
                __builtin_amdgcn_sched_barrier(0); MM4(d, cb, 4); acc[d] *= iw1; __builtin_amdgcn_sched_barrier(0);
                if (d < 3) {
#pragma unroll
                    for (int s_ = 0; s_ < 4; ++s_) { const bf16x8 t_ = ca[s_]; ca[s_] = cc[s_]; cb[s_] = t_; } } }
        } else {
#pragma unroll
            for (int d = 0; d < 4; ++d) { acc[d] = f32x16{}; bf16x8 ca[4], cb[4]; CLD4(ca, d, 0); CLD4(cb, d, 4);
                MM4(d, ca, 0); MM4(d, cb, 4); acc[d] *= iw1; asm volatile("" ::: "memory"); __builtin_amdgcn_sched_barrier(0); }
        }
#undef CLD4
#undef MM4
        float qn = 0.f;
        { const float* np = P.UN + (size_t)(chain * NCH + cd) * 128 + 8 * hi;
#pragma unroll
          for (int s = 0; s < 8; ++s) { const f32x4 n0 = *(const f32x4*)(np + 16 * s), n1 = *(const f32x4*)(np + 16 * s + 4); const u32x4 w = __builtin_bit_cast(u32x4, qf[s]);
              qn += bflo(w.x) * n0[0] + bfhi(w.x) * n0[1] + bflo(w.y) * n0[2] + bfhi(w.y) * n0[3] + bflo(w.z) * n1[0] + bfhi(w.z) * n1[1] + bflo(w.w) * n1[2] + bfhi(w.w) * n1[3]; }
          qn += __shfl_xor(qn, 32); }
        float dsum = 0.f;
        const int kb_lo = dir ? wid : 0, kb_hi = dir ? 7 : wid;
#pragma unroll 1
        for (int kb = kb_lo; kb <= kb_hi; ++kb) {
            int ll = lane; asm volatile("" : "+v"(ll));
            const int l31 = ll & 31, hi = ll >> 5;
            f32x16 S = f32x16{};
#pragma unroll
            for (int s = 0; s < 8; ++s) { const bf16x8 A = *(const LAS bf16x8*)(KS + (32 * kb + l31) * 136 + 16 * s + 8 * hi); S = mfma32(A, qf[s], S); if ((s & 3) == 3) __builtin_amdgcn_sched_barrier(0); }
            const bool diag = (kb == wid);
#pragma unroll
            for (int i = 0; i < 4; ++i) { const f32x4 a4 = *(const LAS f32x4*)(PA + dir * 256 + 32 * kb + 8 * i + 4 * hi);
#pragma unroll
                for (int e = 0; e < 4; ++e) { const int key = 32 * kb + 8 * i + 4 * hi + e; const bool ok = !diag || (dir ? (key >= o1) : (key <= o1));
                    const float p = ok ? S[4 * i + e] * __expf(fminf(a4[e] - mu1, 0.f)) : 0.f; dsum += p; S[4 * i + e] = p; } }
            u32x4 w0, w1; w0.x = pk2(S[0], S[1]); w0.y = pk2(S[2], S[3]); w0.z = pk2(S[4], S[5]); w0.w = pk2(S[6], S[7]);
            w1.x = pk2(S[8], S[9]); w1.y = pk2(S[10], S[11]); w1.z = pk2(S[12], S[13]); w1.w = pk2(S[14], S[15]);
            const bf16x8 pf0 = __builtin_bit_cast(bf16x8, w0), pf1 = __builtin_bit_cast(bf16x8, w1);
#pragma unroll
            for (int d = 0; d < 4; ++d) { const LAS bf16_t* vp = VT + (32 * d + l31) * 264 + 32 * kb + 4 * hi;
                u32x4 A0, A1; { const u32x2 lo = *(const LAS u32x2*)vp, hh = *(const LAS u32x2*)(vp + 8); A0 = (u32x4){lo.x, lo.y, hh.x, hh.y}; }
                { const u32x2 lo = *(const LAS u32x2*)(vp + 16), hh = *(const LAS u32x2*)(vp + 24); A1 = (u32x4){lo.x, lo.y, hh.x, hh.y}; }
                acc[d] = mfma32(__builtin_bit_cast(bf16x8, A0), pf0, acc[d]); acc[d] = mfma32(__builtin_bit_cast(bf16x8, A1), pf1, acc[d]); __builtin_amdgcn_sched_barrier(0); }
        }
        dsum += __shfl_xor(dsum, 32);
        const float den = iw1 * qn + dsum, dinv = 1.f / fmaxf(fabsf(den), fl1);
#pragma unroll
        for (int d = 0; d < 4; ++d) { if (dir == 0) hs[d] = acc[d] * dinv; else hs[d] += acc[d] * dinv; }
    }
    float ss = 0.f;
#pragma unroll
    for (int d = 0; d < 4; ++d)
#pragma unroll
        for (int r = 0; r < 16; ++r) ss += hs[d][r] * hs[d][r];
    ss += __shfl_xor(ss, 32);
    const float rn = rsqrtf(ss * (1.f / 128.f) + NORM_EPS);
#pragma unroll
    for (int dd = 0; dd < 2; ++dd) {
        int ll = lane; asm volatile("" : "+v"(ll)); const int hi = ll >> 5, o1 = 32 * wid + (ll & 31);
        u32x2 mo[8]; f32x4 g4[8];
        { const bf16_t* mp_ = P.HVO + (t0 + o1) * 1024 + 512 + h * 128 + 64 * dd + 4 * hi;
#pragma unroll
          for (int j = 0; j < 8; ++j) mo[j] = *(const u32x2*)(mp_ + 8 * j); }
#pragma unroll
        for (int j = 0; j < 8; ++j) g4[j] = *(const f32x4*)(P.g_on + h * 128 + 64 * dd + 8 * j + 4 * hi);
#pragma unroll
        for (int j = 0; j < 8; ++j) { const int d = 2 * dd + (j >> 2), i = j & 3; const u32x2 m = mo[j]; bf16_t* mp = P.YM + (t0 + o1) * 1024 + h * 128 + 64 * dd + 8 * j + 4 * hi;
            u32x2 w; w.x = pk2(hs[d][4 * i] * rn * g4[j][0] * sigmoidf_(bflo(m.x)), hs[d][4 * i + 1] * rn * g4[j][1] * sigmoidf_(bfhi(m.x)));
            w.y = pk2(hs[d][4 * i + 2] * rn * g4[j][2] * sigmoidf_(bflo(m.y)), hs[d][4 * i + 3] * rn * g4[j][3] * sigmoidf_(bfhi(m.y)));
            *(u32x2*)mp = w; }
        asm volatile("" ::: "memory"); __builtin_amdgcn_sched_barrier(0); }
    __syncthreads();
}

#define XB_TMO      128
#define XB_MISMATCH 192
#define XB_XCNT(j)  (256  + 64 * (j))
#define XB_XSUB(j)  (1280 + 64 * (j))
#define XB_XGEN(j)  (2304 + 64 * (j))
#define XB_TOP      3328
#define XB_TOPGEN   3392
#define XCD_BAR_WORDS 3456
#define XB_SPIN_CAP (1u << 18)
__device__ __forceinline__ unsigned xb_ld(unsigned* p)              { return __hip_atomic_load(p, __ATOMIC_RELAXED, __HIP_MEMORY_SCOPE_AGENT); }
__device__ __forceinline__ unsigned xb_add(unsigned* p, unsigned v) { return __hip_atomic_fetch_add(p, v, __ATOMIC_RELAXED, __HIP_MEMORY_SCOPE_AGENT); }
__device__ __forceinline__ unsigned xb_xcc_id() { return (unsigned)__builtin_amdgcn_s_getreg((3 << 11) | 20) & 0xFu; }
#define XB_SPIN(cond, bar) do { unsigned _sp = 0; while (cond) { __builtin_amdgcn_s_sleep(1); \
    if ((++_sp & 255u) == 0u) { if (xb_ld(&(bar)[XB_TMO])) break; if (_sp > XB_SPIN_CAP) { atomicAdd(&(bar)[XB_TMO], 1u); break; } } } } while (0)
struct XcdBarrier { unsigned* bar; unsigned x; volatile LAS unsigned* st; };
__device__ __forceinline__ XcdBarrier xcd_barrier_post(unsigned* bar, volatile LAS unsigned* st) {
    XcdBarrier b; b.bar = bar; b.x = xb_xcc_id(); b.st = st;
    if (threadIdx.x == 0) { if (b.x != (blockIdx.x & 7u)) (void)xb_add(&bar[XB_MISMATCH], 1u); (void)xb_add(&bar[XB_XCNT(b.x)], 1u); }
    return b;
}
__device__ __forceinline__ void xcd_barrier_complete(unsigned* bar, unsigned x, unsigned& nloc, unsigned& nx) {
    const unsigned G = gridDim.x * gridDim.y * gridDim.z;
    unsigned sum, cnt, mine, sp = 0u;
    for (;;) {
        sum = 0u; cnt = 0u; mine = 0u;
#pragma unroll
        for (unsigned j = 0; j < 16; ++j) { const unsigned c = xb_ld(&bar[XB_XCNT(j)]); sum += c; cnt += (c > 0u) ? 1u : 0u; mine = (j == x) ? c : mine; }
        if (sum == G) break;
        __builtin_amdgcn_s_sleep(1);
        if ((++sp & 255u) == 0u) { if (xb_ld(&bar[XB_TMO])) break; if (sp > XB_SPIN_CAP) { atomicAdd(&bar[XB_TMO], 1u); break; } }
    }
    nloc = mine > 0u ? mine : 1u; nx = cnt > 0u ? cnt : 1u;
}
__device__ __forceinline__ void xcd_barrier(const XcdBarrier& b) {
    asm volatile("s_waitcnt vmcnt(0)" ::: "memory");
    __syncthreads();
    if (threadIdx.x == 0) {
        unsigned* bar = b.bar;
        __builtin_amdgcn_s_waitcnt(0);
        unsigned nloc = b.st[0], nx = b.st[1];
        if (nloc == 0u) { xcd_barrier_complete(bar, b.x, nloc, nx); b.st[0] = nloc; b.st[1] = nx; }
        const unsigned old = xb_add(&bar[XB_XSUB(b.x)], 1u);
        const unsigned gen = old / nloc;
        if (old + 1u == (gen + 1u) * nloc) {
            __builtin_amdgcn_fence(__ATOMIC_RELEASE, "agent");
            asm volatile("s_waitcnt vmcnt(0)" ::: "memory");
            const unsigned og = xb_add(&bar[XB_TOP], 1u);
            const unsigned tg = og / nx;
            if (og + 1u == (tg + 1u) * nx) xb_add(&bar[XB_TOPGEN], 1u);
            else XB_SPIN(xb_ld(&bar[XB_TOPGEN]) == tg, bar);
            __builtin_amdgcn_fence(__ATOMIC_ACQUIRE, "agent");
            xb_add(&bar[XB_XGEN(b.x)], 1u);
            asm volatile("s_waitcnt vmcnt(0)" ::: "memory");
        } else {
            XB_SPIN(xb_ld(&bar[XB_XGEN(b.x)]) == gen, bar);
            __builtin_amdgcn_fence(__ATOMIC_ACQUIRE, "agent");
            asm volatile("s_waitcnt vmcnt(0)" ::: "memory");
        }
    }
    __syncthreads();
}

__device__ __forceinline__ void xcd_local_barrier(const XcdBarrier& b) {
    asm volatile("s_waitcnt vmcnt(0)" ::: "memory");
    __syncthreads();
    if (threadIdx.x == 0) {
        unsigned* bar = b.bar;
        __builtin_amdgcn_s_waitcnt(0);
        const unsigned nloc = b.st[0];
        const unsigned old = xb_add(&bar[XB_XSUB(b.x)], 1u);
        const unsigned gen = old / nloc;
        if (old + 1u == (gen + 1u) * nloc) { xb_add(&bar[XB_XGEN(b.x)], 1u); }
        else { XB_SPIN(xb_ld(&bar[XB_XGEN(b.x)]) == gen, bar); }
        __builtin_amdgcn_fence(__ATOMIC_ACQUIRE, "agent");
        asm volatile("s_waitcnt vmcnt(0)" ::: "memory");
    }
    __syncthreads();
}

__device__ __forceinline__ void xcd_local_barrier_post(const XcdBarrier& b, unsigned* gcnt) {
    asm volatile("s_waitcnt vmcnt(0)" ::: "memory");
    __syncthreads();
    if (threadIdx.x == 0) {
        unsigned* bar = b.bar;
        __builtin_amdgcn_s_waitcnt(0);
        const unsigned nloc = b.st[0];
        const unsigned old = xb_add(&bar[XB_XSUB(b.x)], 1u);
        const unsigned gen = old / nloc;
        if (old + 1u == (gen + 1u) * nloc) {
            xb_add(&bar[XB_XGEN(b.x)], 1u);
            __builtin_amdgcn_fence(__ATOMIC_RELEASE, "agent"); asm volatile("s_waitcnt vmcnt(0)" ::: "memory");
            (void)xb_add(gcnt, 1u);
        } else { XB_SPIN(xb_ld(&bar[XB_XGEN(b.x)]) == gen, bar); }
        __builtin_amdgcn_fence(__ATOMIC_ACQUIRE, "agent");
        asm volatile("s_waitcnt vmcnt(0)" ::: "memory");
    }
    __syncthreads();
}
__device__ __forceinline__ void count_wait(unsigned* cnt, unsigned target) {
    if (threadIdx.x == 0) { unsigned sp_ = 0; while (xb_ld(cnt) < target) { __builtin_amdgcn_s_sleep(2); if (++sp_ > (1u << 22)) break; }
        __builtin_amdgcn_fence(__ATOMIC_ACQUIRE, "agent"); asm volatile("s_waitcnt vmcnt(0)" ::: "memory"); }
    __syncthreads();
}

__device__ __forceinline__ float wave_sum(float v) {
#pragma unroll
    for (int o = 1; o < 64; o <<= 1) v += __shfl_xor(v, o);
    return v;
}
__device__ __forceinline__ int map_row(int mode, int n) {
    if (mode == 1) { if (n < 672) return n; if (n < 2720) return n + 96; if (n < 2736) return n - 2048; return n + 80; }
    if (mode == 2) { const int hh = n / 96, d = n % 96; if (d < 64) return n; const int r = d - 64;
        const int p = (r < 16) ? 8 * (r >> 2) + (r & 3) : 8 * ((r - 16) >> 2) + 4 + ((r - 16) & 3); return hh * 96 + 64 + p; }
    return n;
}
__device__ __forceinline__ void p0_transpose_item(const float* __restrict__ W, int K, int N, bf16_t* WT, int ldw, int mode, const float* __restrict__ gain, int item, int lane) {
    const int nblk = (N + 63) / 64, kb = item / nblk, nb = item % nblk, k0 = 32 * kb, n = 64 * nb + lane;
    if (n < N) {
        float v[32];
#pragma unroll
        for (int i = 0; i < 32; ++i) v[i] = __builtin_nontemporal_load(&W[(size_t)(k0 + i) * N + n]);
        if (gain) {
#pragma unroll
            for (int i = 0; i < 32; ++i) v[i] *= gain[k0 + i]; }
        bf16_t* dst = WT + (size_t)map_row(mode, n) * ldw + k0;
#pragma unroll
        for (int j = 0; j < 4; ++j) { u32x4 o; o.x = pk2(v[8 * j], v[8 * j + 1]); o.y = pk2(v[8 * j + 2], v[8 * j + 3]); o.z = pk2(v[8 * j + 4], v[8 * j + 5]); o.w = pk2(v[8 * j + 6], v[8 * j + 7]);
            *(u32x4*)(dst + 8 * j) = o; }
    }
}
__device__ __forceinline__ void sincos_acc(float ang, float& sn, float& cs) {
    const double x = (double)ang; const double kq = __builtin_rint(x * 0.63661977236758134308); const double r = x - kq * 1.57079632679489661923; const double r2 = r * r;
    const double s = r * (1.0 + r2 * (-1.0 / 6 + r2 * (1.0 / 120 + r2 * (-1.0 / 5040 + r2 * (1.0 / 362880 + r2 * (-1.0 / 39916800 + r2 * (1.0 / 6227020800.0)))))));
    const double c = 1.0 + r2 * (-0.5 + r2 * (1.0 / 24 + r2 * (-1.0 / 720 + r2 * (1.0 / 40320 + r2 * (-1.0 / 3628800 + r2 * (1.0 / 479001600.0 + r2 * (-1.0 / 87178291200.0)))))));
    const int q = ((int)kq) & 3;
    const double ss = (q == 0) ? s : (q == 1) ? c : (q == 2) ? -s : -c, cc = (q == 0) ? c : (q == 1) ? -s : (q == 2) ? -c : s;
    sn = (float)ss; cs = (float)cc;
}

constexpr int LDS_BYTES = 149504;
constexpr int MISC_OFF = LDS_BYTES - 128;
struct Args { const void* in[20]; float* out; unsigned char* ws; int ph_lo, ph_hi, li, pad; };

#define MKP() \
    Ptrs P; \
    P.x = (const float*)args.in[0]; P.pos = (const int*)args.in[1]; P.g_mix = (const float*)args.in[2]; P.w_in = (const float*)args.in[3]; P.g_q = (const float*)args.in[4]; \
    P.w_uq = (const float*)args.in[5]; P.g_kv = (const float*)args.in[6]; P.w_ukv = (const float*)args.in[7]; P.conv_w = (const float*)args.in[8]; P.conv_b = (const float*)args.in[9]; \
    P.ig_b = (const float*)args.in[10]; P.fg_b = (const float*)args.in[11]; P.g_on = (const float*)args.in[12]; P.w_bm = (const float*)args.in[13]; P.w_bl = (const float*)args.in[14]; \
    P.w_out = (const float*)args.in[15]; P.g_mlp = (const float*)args.in[16]; P.w_up = (const float*)args.in[17]; P.w_dn = (const float*)args.in[18]; P.g_fin = (const float*)args.in[19]; \
    P.out = args.out; P.ws = args.ws; \
    P.WinT = (bf16_t*)(ws + WS_WIN); P.WuqT = (bf16_t*)(ws + WS_WUQ); P.WukvT = (bf16_t*)(ws + WS_WUKV); P.WbmT = (bf16_t*)(ws + WS_WBM); P.WblT = (bf16_t*)(ws + WS_WBL); \
    P.WoutT = (bf16_t*)(ws + WS_WOUT); P.WupT = (bf16_t*)(ws + WS_WUP); P.WdnT = (bf16_t*)(ws + WS_WDN); \
    P.ROPE = (float*)(ws + WS_ROPE); P.SSQ = (float*)(ws + WS_SSQ); P.SSQ1 = (float*)(ws + WS_SSQ1); P.SSQ2 = (float*)(ws + WS_SSQ2); P.G32 = (float*)(ws + WS_G32); \
    P.UN = (float*)(ws + WS_UN); P.BL = (float*)(ws + WS_BL); P.ML = (float*)(ws + WS_ML); P.MP = (float*)(ws + WS_MP); \
    P.H0 = (bf16_t*)(ws + WS_H0); P.HQK = (bf16_t*)(ws + WS_HQK); P.HVO = (bf16_t*)(ws + WS_HVO); P.HG = (bf16_t*)(ws + WS_HG); \
    P.XN = (bf16_t*)(ws + WS_XN); P.UC = (bf16_t*)(ws + WS_UC); P.QC = (bf16_t*)(ws + WS_QC); P.KC = (bf16_t*)(ws + WS_KC); P.VTG = (bf16_t*)(ws + WS_VTG); P.G1 = (bf16_t*)(ws + WS_G1); P.MERGED = (bf16_t*)(ws + WS_MERGED); P.X1B = (bf16_t*)(ws + WS_X1B); \
    P.ACT = (bf16_t*)(ws + WS_ACT); P.YA = (bf16_t*)(ws + WS_YA); P.YM = (bf16_t*)(ws + WS_YM); \
    P.Q = (bf16_t*)((unsigned char*)args.out + DO_Q); P.KV = (bf16_t*)((unsigned char*)args.out + DO_KV); P.KR = (bf16_t*)((unsigned char*)args.out + DO_KR);

__global__ void __launch_bounds__(NWAVES * 64, 2) mk_fwd(Args args) {
    extern __shared__ __attribute__((aligned(16))) unsigned char lds_raw[];
    LAS unsigned char* lds = (LAS unsigned char*)lds_raw;
    const int tid = threadIdx.x, lane = tid & 63, wave = __builtin_amdgcn_readfirstlane(tid >> 6);
    const int G = gridDim.x; const int bx = blockIdx.x; const int vcu = (G % 8 == 0) ? (bx % 8) * (G / 8) + bx / 8 : bx;
    unsigned char* ws = args.ws;
    volatile LAS unsigned* MISC = (volatile LAS unsigned*)(lds + MISC_OFF);
    { int t0_ = tid; asm volatile("" : "+v"(t0_)); for (int u = t0_; u < (LDS_BYTES - 131072) / 4; u += NWAVES * 64) ((LAS unsigned*)(lds + 131072))[u] = 0u; }
    __syncthreads();
#if !MK_SPLIT
    XcdBarrier bar = xcd_barrier_post((unsigned*)(ws + WS_CTL) + CW_BAR, MISC + 8);
#define SEAM(k) do { if (IN((k) + 1)) xcd_barrier(bar); } while (0)
#define SEAML(k) do { if (IN((k) + 1)) { if (MISC[12]) xcd_local_barrier(bar); else xcd_barrier(bar); } } while (0)
#else
#define SEAM(k) do { } while (0)
#define SEAML(k) do { } while (0)
#endif
    const int lo = args.ph_lo, hi = args.ph_hi;
#ifndef PH_MASK
#define PH_MASK 0x3ff
#endif
#define IN(k) (((PH_MASK >> (k)) & 1) && lo <= (k) && (k) < hi)
    const int gw = vcu * NWAVES + wave, NGW = G * NWAVES;

    if (IN(0)) { MKP();
#pragma unroll 1
      for (int rep = 0; rep < ((PROBE_DUP & 16) ? 2 : 1); ++rep) {
        constexpr int I_IN = (1024 / 32) * ((IN_COLS + 63) / 64), I_UQ = (384 / 32) * (768 / 64), I_UKV = (256 / 32) * (1024 / 64), I_BM = (512 / 32) * (1024 / 64), I_BL = I_BM,
                      I_OUT = (1024 / 32) * (1024 / 64), I_UP = (1024 / 32) * (4096 / 64), I_DN = (4096 / 32) * (1024 / 64);
        constexpr int NITEMS = I_IN + I_UQ + I_UKV + I_BM + I_BL + I_OUT + I_UP + I_DN;
        constexpr int NEARLY = I_IN + I_UQ + I_UKV;
#pragma unroll 1
      for (int stage = 0; stage < 2; ++stage) {
#pragma unroll 1
            for (int it = (stage ? NEARLY : 0) + gw; it < (stage ? NITEMS : NEARLY); it += NGW) {
                int r = it; const float* W; const float* gn = nullptr; bf16_t* WT; int K_, N_, mode = 0, ldw = 0;
                if (r < I_IN) { W = P.w_in; K_ = 1024; N_ = IN_COLS; WT = P.WinT; mode = 1; }
                else if ((r -= I_IN) < I_UQ) { W = P.w_uq; K_ = 384; N_ = 768; WT = P.WuqT; mode = 2; gn = P.g_q; }
                else if ((r -= I_UQ) < I_UKV) { W = P.w_ukv; K_ = 256; N_ = 1024; WT = P.WukvT; gn = P.g_kv; }
                else if ((r -= I_UKV) < I_BM) { W = P.w_bm; K_ = 512; N_ = 1024; WT = P.WbmT; ldw = 1024; }
                else if ((r -= I_BM) < I_BL) { W = P.w_bl; K_ = 512; N_ = 1024; WT = P.WbmT + 512; ldw = 1024; }
                else if ((r -= I_BL) < I_OUT) { W = P.w_out; K_ = 1024; N_ = 1024; WT = P.WoutT; }
                else if ((r -= I_OUT) < I_UP) { W = P.w_up; K_ = 1024; N_ = 4096; WT = P.WupT; gn = P.g_mlp; }
                else { r -= I_UP; W = P.w_dn; K_ = 4096; N_ = 1024; WT = P.WdnT; }
                p0_transpose_item(W, K_, N_, WT, ldw ? ldw : K_, mode, gn, r, lane);
            }
        if (stage == 0) {
        for (int i = vcu * 512 + tid; i < 80 * 1024 / 8; i += G * 512) *(u32x4*)(P.WinT + (size_t)688 * 1024 + (size_t)i * 8) = (u32x4){0u, 0u, 0u, 0u};
#pragma unroll 1
        for (int m = gw; m < M; m += 2 * NGW) {
            const int m2 = m + NGW;
            const f32x4* xa = (const f32x4*)(P.x + (size_t)m * 1024) + lane; const f32x4* xb = (const f32x4*)(P.x + (size_t)(m2 < M ? m2 : m) * 1024) + lane;
            f32x4 va[4], vb[4]; float sa = 0.f, sb = 0.f;
#pragma unroll
            for (int j = 0; j < 4; ++j) { va[j] = __builtin_nontemporal_load(&xa[64 * j]); vb[j] = __builtin_nontemporal_load(&xb[64 * j]); }
#pragma unroll
            for (int j = 0; j < 4; ++j) { sa += dot4(va[j]); sb += dot4(vb[j]); }
            const float ra = rsqrtf(wave_sum(sa) * (1.f / 1024.f) + NORM_EPS), rb = rsqrtf(wave_sum(sb) * (1.f / 1024.f) + NORM_EPS);
            u32x2* oa = (u32x2*)(P.XN + (size_t)m * 1024) + lane; u32x2* ob = (u32x2*)(P.XN + (size_t)m2 * 1024) + lane;
#pragma unroll
            for (int j = 0; j < 4; ++j) { const f32x4 g4 = *((const f32x4*)P.g_mix + lane + 64 * j); u32x2 w;
                w.x = pk2(va[j][0] * ra * g4[0], va[j][1] * ra * g4[1]); w.y = pk2(va[j][2] * ra * g4[2], va[j][3] * ra * g4[3]); st8wt(oa + 64 * j, w);
                if (m2 < M) { w.x = pk2(vb[j][0] * rb * g4[0], vb[j][1] * rb * g4[1]); w.y = pk2(vb[j][2] * rb * g4[2], vb[j][3] * rb * g4[3]); st8wt(ob + 64 * j, w); } }
        }
#if !MK_SPLIT
          if (tid == 0) { unsigned nloc_ = MISC[8], nx_ = MISC[9]; if (nloc_ == 0u) { xcd_barrier_complete((unsigned*)(ws + WS_CTL) + CW_BAR, bar.x, nloc_, nx_); MISC[8] = nloc_; MISC[9] = nx_; }
              MISC[12] = (G == 256 && xb_ld((unsigned*)(ws + WS_CTL) + CW_BAR + XB_MISMATCH) == 0u) ? 1u : 0u; }
          __syncthreads();
          if (MISC[12]) xcd_local_barrier_post(bar, (unsigned*)(ws + WS_CTL) + CW_G0);
#endif
        } else {
        const bool xl_ = !MK_SPLIT && MISC[12];
        for (int i = xl_ ? (vcu >> 5) * 32768 + (vcu & 31) * 512 + tid : vcu * 512 + tid; i < (xl_ ? ((vcu >> 5) + 1) * 32768 : M * 16); i += xl_ ? 16384 : G * 512) { const int m = i >> 4, j = i & 15;
            const float invf = (float)exp(-(double)j * (9.210340371976184 / 16.0));
            const float ang = (float)P.pos[m] * invf; float sn, cs; sincos_acc(ang, sn, cs);
            P.ROPE[(size_t)m * 32 + j] = cs; P.ROPE[(size_t)m * 32 + 16 + j] = sn; }
        }
      }
      }
#if !MK_SPLIT
        if (MISC[12]) { if (IN(1)) count_wait((unsigned*)(ws + WS_CTL) + CW_G0, MISC[9]); }
        else
#endif
        SEAM(0);
    }
    if (IN(1)) { MKP();
        pg8::Gemm g{P.XN, P.WinT, M, NIN, 1024, 1024, 1024}; pg8::StaticOrder S; S.init(M, NIN, G, bx);
        EpiIn E{P.H0, P.HQK, P.HVO, P.HG, P.SSQ, P.G32};
#pragma unroll 1
        for (int rep = 0; rep < ((PROBE_DUP & 4) ? 2 : 1); ++rep)
        pg8::gemm_phase<EpiIn, pg8::StaticOrder>(lds, g, S, E);
#if !MK_SPLIT
        if (MISC[12]) { if (IN(2)) xcd_local_barrier_post(bar, (unsigned*)(ws + WS_CTL) + CW_G1); }
        else
#endif
        SEAM(1);
    }
    if (IN(2)) { MKP();
#ifndef P2M
#define P2M 15
#endif
      {
        if (PROBE_DUP & 32) { { pg8::Gemm g{P.H0, P.WuqT, M, 768, 384, 768, 384}; pg8::StaticOrder S; S.init(M, 768, G, bx); EpiQ E{P.Q, P.SSQ, P.ROPE}; pg8::gemm_phase<EpiQ, pg8::StaticOrder>(lds, g, S, E); }
          { pg8::Gemm g{P.H0 + 384, P.WukvT, M, 1024, 256, 768, 256}; pg8::StaticOrder S; S.init(M, 1024, G, bx); EpiKV E{P.KV, P.SSQ}; pg8::gemm_phase<EpiKV, pg8::StaticOrder>(lds, g, S, E); } }
        if (P2M & 1) { pg8::Gemm g{P.H0, P.WuqT, M, 768, 384, 768, 384}; pg8::StaticOrder S; S.init(M, 768, G, bx); EpiQ E{P.Q, P.SSQ, P.ROPE};
          pg8::gemm_phase<EpiQ, pg8::StaticOrder>(lds, g, S, E); }
        if (P2M & 2) { pg8::Gemm g{P.H0 + 384, P.WukvT, M, 1024, 256, 768, 256}; pg8::StaticOrder S; S.init(M, 1024, G, bx); EpiKV E{P.KV, P.SSQ};
          pg8::gemm_phase<EpiKV, pg8::StaticOrder>(lds, g, S, E); }
        const bool xloc = !MK_SPLIT && MISC[12];
        const int kr0 = xloc ? ((vcu >> 5) * 8192 + (vcu & 31) * 512 + tid) : vcu * 512 + tid, kr1 = xloc ? (((vcu & 31) < 16) ? ((vcu >> 5) + 1) * 8192 : 0) : M * 4, krs = xloc ? 16384 : G * 512;
        if (P2M & 4) for (int i = kr0; i < kr1; i += krs) { const int m = i >> 2, gq = i & 3;
            const u32x2 a = *(const u32x2*)(P.H0 + (size_t)m * 768 + 640 + 4 * gq), bb = *(const u32x2*)(P.H0 + (size_t)m * 768 + 656 + 4 * gq);
            const f32x4 x1 = (f32x4){bflo(a.x), bfhi(a.x), bflo(a.y), bfhi(a.y)}, x2 = (f32x4){bflo(bb.x), bfhi(bb.x), bflo(bb.y), bfhi(bb.y)};
            const f32x4 c = *(const f32x4*)(P.ROPE + (size_t)m * 32 + 4 * gq), s = *(const f32x4*)(P.ROPE + (size_t)m * 32 + 16 + 4 * gq);
            *(u32x4*)(P.KR + (size_t)m * 32 + 8 * gq) = pack8(x1 * c - x2 * s, x2 * c + x1 * s); }
        __syncthreads();
      }
#if !MK_SPLIT
        if (MISC[12]) count_wait((unsigned*)(ws + WS_CTL) + CW_G1, MISC[9]);
#endif
#pragma unroll 1
        for (int rep = 0; rep < ((PROBE_DUP & 2) ? 2 : 1); ++rep)
        if (P2M & 8) for (int unit = vcu; unit < 256; unit += G) mlstm_pass1_unit(P, lds, unit >> 7, (unit >> 5) & 3, unit & 31, tid);
#if !MK_SPLIT
        if (MISC[12]) { if (IN(3)) xcd_local_barrier_post(bar, (unsigned*)(ws + WS_CTL) + CW_G2); }
        else
#endif
        SEAM(2);
    }
    if (IN(3)) { MKP(); mlstm_pass2(P, lds, vcu, G, tid);
#if !MK_SPLIT
        if (MISC[12]) {
            asm volatile("s_waitcnt vmcnt(0)" ::: "memory"); __syncthreads();
            if (tid == 0) (void)xb_add((unsigned*)(ws + WS_CTL) + CW_S3 + 64 * (bx & 7), 1u);
        } else
#endif
        SEAM(3); }
    if (IN(4)) { MKP();
#if !MK_SPLIT
        if (MISC[12]) count_wait((unsigned*)(ws + WS_CTL) + CW_S3 + 64 * (bx & 7), MISC[8]);
#endif
#pragma unroll 1
        for (int rep = 0; rep < ((PROBE_DUP & 512) ? 2 : 1); ++rep)
        for (int unit = vcu; unit < 256; unit += G) mlstm_pass3_unit(P, lds, unit >> 7, (unit >> 5) & 3, unit & 31, tid);
#if !MK_SPLIT
        if (MISC[12]) count_wait((unsigned*)(ws + WS_CTL) + CW_G2, MISC[9]);
#endif
#pragma unroll 1
        for (int rep = 0; rep < ((PROBE_DUP & 1) ? 2 : 1); ++rep)
#pragma unroll 1
        for (int i = 0; i < 2 * ((512 + 2 * G - 1) / (2 * G)); ++i) { const int un = (i >> 1) * 2 * G + vcu * 2 + (i & 1); if (un >= 512) break;
            const int bh = un >> 5, qb = un & 31, b = bh >> 3, h = bh & 7; const long rowb = (long)b * SEQ;
            att::attn_unit(P.Q + (rowb + qb * 256) * 768 + h * 96, P.KV + rowb * 1024 + h * 128, P.KR + rowb * 32, P.YA + (rowb + qb * 256) * 1024 + h * 64, lds); }
        __syncthreads();
        SEAM(4);
    }
    if (IN(5)) { MKP();
      {
        { pg8::Gemm g{P.YA, P.WbmT, M, 1024, 1024, 1024, 1024}; pg8::StaticOrder S; S.init(M, 1024, G, bx); EpiMergeF E{P.MERGED, P.HG, (size_t)((const char*)P.HVO - (const char*)P.YA)};
          pg8::gemm_phase<EpiMergeF, pg8::StaticOrder>(lds, g, S, E); }
      }
#if !MK_SPLIT
        if (IN(6) && MISC[12]) { asm volatile("s_waitcnt vmcnt(0)" ::: "memory"); __syncthreads(); if (tid == 0) (void)xb_add((unsigned*)(ws + WS_CTL) + CW_P5, 1u); }
#endif
        SEAML(5);
    }
    if (IN(6)) { MKP();
        pg8::Gemm g{P.MERGED, P.WoutT, M, 1024, 1024, 1024, 1024}; pg8::StaticOrder S; S.init(M, 1024, G, bx); EpiRes E{P.x, (G == 256) ? nullptr : P.out, P.X1B, P.SSQ1, true};
#pragma unroll 1
        for (int rep = 0; rep < ((PROBE_DUP & 128) ? 2 : 1); ++rep)
        pg8::gemm_phase<EpiRes, pg8::StaticOrder>(lds, g, S, E);
        SEAML(6);
#if !MK_SPLIT
        if (IN(7) && MISC[12]) { if (tid == 0) { unsigned* c5_ = (unsigned*)(ws + WS_CTL) + CW_P5; unsigned sp_ = 0;
              while (xb_ld(c5_) < (unsigned)G) { __builtin_amdgcn_s_sleep(2); if (++sp_ > (1u << 22)) break; }
              __builtin_amdgcn_fence(__ATOMIC_ACQUIRE, "agent"); asm volatile("s_waitcnt vmcnt(0)" ::: "memory"); }
          __syncthreads(); }
#endif
    }
    if (IN(7)) { MKP();
        pg8::Gemm g{P.X1B, P.WupT, M, DFF, 1024, 1024, 1024}; pg8::StaticOrder S; S.init(M, DFF, G, bx); EpiUp E{P.ACT, P.SSQ1};
#pragma unroll 1
        for (int rep = 0; rep < ((PROBE_DUP & 8) ? 2 : 1); ++rep)
        pg8::gemm_phase<EpiUp, pg8::StaticOrder>(lds, g, S, E);
        SEAML(7);
    }
    if (IN(8)) { MKP();
        pg8::Gemm g{P.ACT, P.WdnT, M, 1024, DFF, DFF, DFF}; pg8::StaticOrder S; S.init(M, 1024, G, bx);
        if (G == 256) {
            EpiFinal E{P.X1B, P.out, P.g_fin, P.SSQ2, (unsigned*)(ws + WS_CTL) + CW_CNT};
            pg8::gemm_phase<EpiFinal, pg8::StaticOrder>(lds, g, S, E);
        } else {
            EpiRes E{P.out, P.out, nullptr, P.SSQ2, false};
            pg8::gemm_phase<EpiRes, pg8::StaticOrder>(lds, g, S, E);
            SEAM(8);
        }
    }
    if (IN(9) && G != 256) { MKP(); int t9_ = tid; asm volatile("" : "+v"(t9_)); const int lane = t9_ & 63;
        for (int m = gw; m < M; m += NGW) { float ss = 0.f;
#pragma unroll
            for (int p = 0; p < 16; ++p) ss += P.SSQ2[(size_t)p * M + m];
            const float rstd = rsqrtf(ss * (1.f / 1024.f) + NORM_EPS);
            f32x4* xr = (f32x4*)(P.out + (size_t)m * 1024) + lane;
#pragma unroll
            for (int j = 0; j < 4; ++j) { const f32x4 g4 = *((const f32x4*)P.g_fin + lane + 64 * j); xr[64 * j] = xr[64 * j] * rstd * g4; } }
    }
#undef IN
#undef SEAM
}

extern "C" void kernel_launch(void* const* d_in, const int* in_sizes, int n_in, void* d_out, int out_size, void* d_ws, size_t ws_size, hipStream_t stream) {
    static int grid = 0;
    if (grid == 0) {
        if (n_in != 20 || in_sizes[0] != M * DMODEL || out_size != M * DMODEL || ws_size < WS_END) { fprintf(stderr, "kernel_launch: shape mismatch (n_in %d in0 %d out %d ws %zu)\n", n_in, n_in > 0 ? in_sizes[0] : -1, out_size, ws_size); grid = -1; return; }
        int dev = 0, cus = 0;
        if (hipGetDevice(&dev) != hipSuccess || hipDeviceGetAttribute(&cus, hipDeviceAttributeMultiprocessorCount, dev) != hipSuccess) { grid = -1; return; }
        if (hipFuncSetAttribute((const void*)mk_fwd, hipFuncAttributeMaxDynamicSharedMemorySize, LDS_BYTES) != hipSuccess) { fprintf(stderr, "kernel_launch: hipFuncSetAttribute failed\n"); grid = -1; return; }
        int per_cu = 0;
        if (hipOccupancyMaxActiveBlocksPerMultiprocessor(&per_cu, (const void*)mk_fwd, NWAVES * 64, LDS_BYTES) != hipSuccess || per_cu < 1) fprintf(stderr, "kernel_launch: occupancy query reports %d\n", per_cu);
        (void)hipGetLastError();
        grid = cus;
    }
    if (grid < 0) return;
    if (hipMemsetAsync((char*)d_ws + WS_CTL, 0, CTL_ZERO_BYTES, stream) != hipSuccess) { fprintf(stderr, "kernel_launch: memset failed\n"); return; }
    Args a{};
    for (int i = 0; i < 20; ++i) a.in[i] = d_in[i];
    a.out = (float*)d_out; a.ws = (unsigned char*)d_ws;
#if MK_SPLIT
    for (int li = 0; li < NPHASE; ++li) { a.ph_lo = li; a.ph_hi = li + 1; a.li = li;
        hipLaunchKernelGGL(mk_fwd, dim3(grid), dim3(NWAVES * 64), LDS_BYTES, stream, a); }
#else
    a.ph_lo = 0; a.ph_hi = NPHASE; a.li = 0;
    hipLaunchKernelGGL(mk_fwd, dim3(grid), dim3(NWAVES * 64), LDS_BYTES, stream, a);
#endif
    const hipError_t le = hipPeekAtLastError();
    if (le != hipSuccess) fprintf(stderr, "kernel_launch: launch failed: %s\n", hipGetErrorName(le));
}
```

```cpp
#include <hip/hip_runtime.h>
#include <hip/hip_bf16.h>
#include <cstdio>
#include <cstdint>

#ifndef PROBE_DUP
#define PROBE_DUP 0
#endif
#ifndef MK_SPLIT
#define MK_SPLIT 0
#endif

#define LAS __attribute__((address_space(3)))
#define GAS __attribute__((address_space(1)))
typedef unsigned short bf16_t;
typedef short bf16x8 __attribute__((ext_vector_type(8)));
typedef short s16x4 __attribute__((ext_vector_type(4)));
typedef float f32x4 __attribute__((ext_vector_type(4)));
typedef float f32x16 __attribute__((ext_vector_type(16)));
typedef unsigned u32x4 __attribute__((ext_vector_type(4)));
typedef unsigned u32x2 __attribute__((ext_vector_type(2)));
typedef float f32x2_t __attribute__((ext_vector_type(2)));
typedef __bf16 bf16x2_t __attribute__((ext_vector_type(2)));

constexpr int BATCH = 2, SEQ = 8192, DMODEL = 1024, M = BATCH * SEQ;
constexpr int IN_COLS = 4784, NIN = 4864;
constexpr int DFF = 4096;
constexpr float NORM_EPS = 1e-6f;
constexpr int NWAVES = 8;
constexpr int NPHASE = 10;

constexpr size_t MiB = 1u << 20;
constexpr size_t WS_CTL = 0, CTL_ZERO_BYTES = 128 * 1024;
constexpr size_t WS_WIN = 1 * MiB;
constexpr size_t WS_WUQ = WS_WIN + (size_t)NIN * 1024 * 2;
constexpr size_t WS_WUKV = WS_WUQ + 768 * 384 * 2;
constexpr size_t WS_WBM = 12 * MiB, WS_WBL = 13 * MiB, WS_WOUT = 14 * MiB, WS_WUP = 16 * MiB, WS_WDN = 24 * MiB;
constexpr size_t WS_ROPE = 32 * MiB;
constexpr size_t WS_SSQ = 34 * MiB;
constexpr size_t WS_SSQ1 = WS_SSQ + 24 * (size_t)M * 4;
constexpr size_t WS_SSQ2 = WS_SSQ1 + 16 * (size_t)M * 4;
constexpr size_t WS_G32 = WS_SSQ2 + 16 * (size_t)M * 4;
constexpr size_t WS_UN = WS_G32 + (size_t)M * 16 * 4;
constexpr size_t WS_BL = WS_UN + 16 * 128 * 128 * 4;
constexpr size_t WS_ML = WS_BL + 16 * 128 * 4;
constexpr size_t WS_MP = WS_ML + 16 * 128 * 4;
static_assert(WS_MP + 16 * 128 * 4 <= 40 * MiB, "misc region");
static_assert(WS_WUKV + 1024 * 256 * 2 <= WS_WBM, "weights");
constexpr size_t WS_H0 = 40 * MiB, WS_HQK = 64 * MiB, WS_HVO = 96 * MiB, WS_HG = 128 * MiB;
constexpr size_t WS_R = 192 * MiB;
constexpr size_t WS_XN = WS_R, WS_UC = WS_R, WS_QC = WS_R + 16 * MiB, WS_KC = WS_R + 32 * MiB, WS_VTG = WS_R + 48 * MiB, WS_G1 = WS_R, WS_MERGED = WS_R + 32 * MiB, WS_X1B = WS_R;
constexpr size_t WS_ACT = 40 * MiB;
constexpr size_t WS_YA = 40 * MiB;
constexpr size_t WS_YM = WS_YA + 512 * 2;
constexpr size_t WS_END = 256 * MiB;
constexpr size_t DO_Q = 0, DO_KV = 24 * MiB, DO_KR = 56 * MiB;
constexpr int CW_BAR = 4096, CW_CNT = 16384, CW_P5 = 24576, CW_G2 = 24704, CW_G0 = 24768, CW_S3 = 24832, CW_G1 = 25920;
static_assert((CW_BAR + 3456) * 4 <= 128 * 1024 && (CW_CNT + 64 * 64) * 4 <= 128 * 1024, "control words inside the per-call memset");

__device__ __forceinline__ unsigned pk2(float lo, float hi) { f32x2_t v = {lo, hi}; bf16x2_t b = __builtin_convertvector(v, bf16x2_t); return __builtin_bit_cast(unsigned, b); }
__device__ __forceinline__ float bflo(unsigned w) { return __uint_as_float(w << 16); }
__device__ __forceinline__ float bfhi(unsigned w) { return __uint_as_float(w & 0xffff0000u); }
__device__ __forceinline__ float bf2f(bf16_t h) { return __uint_as_float((unsigned)h << 16); }
__device__ __forceinline__ float sigmoidf_(float x) { return __builtin_amdgcn_rcpf(1.f + __expf(-x)); }
__device__ __forceinline__ float dot4(f32x4 a) { return (a[0] * a[0] + a[1] * a[1]) + (a[2] * a[2] + a[3] * a[3]); }
#define LDS_WAIT() asm volatile("s_waitcnt lgkmcnt(0)" ::: "memory")
#define VM_WAIT() asm volatile("s_waitcnt vmcnt(0)" ::: "memory")

namespace pg8 {
#define PG8_LAS __attribute__((address_space(3)))
constexpr int BM = 256, BK = 64, HALF = 128, HTB = HALF * BK * 2, STAGE_BYTES = 8 * HTB, NXCD = 8, WGM = 8;
__host__ __device__ __forceinline__ int lds_byte(int r, int c) { const int st = (r >> 4) * 2 + (c >> 5), rr = r & 15, cc = c & 31, ob = rr * 64 + cc * 2; return st * 1024 + (ob ^ (((ob >> 9) & 1) << 5)); }
__host__ __device__ __forceinline__ void stage_rc(int b, int& R, int& C) { const int st = b / 1024, sb = b % 1024, swz = sb ^ (((sb >> 9) & 1) << 5); R = (st >> 1) * 16 + swz / 64; C = (st & 1) * 32 + (swz % 64) / 2; }
__host__ __device__ __forceinline__ int perm32(int rho) { const int n = rho >> 4, i = rho & 15; return 8 * (i >> 2) + 4 * n + (i & 3); }
struct Unit { int pm, pn; };
struct Gemm { const bf16_t* A; const bf16_t* Bt; int M, N, K, lda, ldb; };
struct StaticOrder {
    int nM, nN, nwg, G, c;
    __host__ __device__ void init(int M_, int N_, int G_, int c_) { nM = M_ / BM; nN = N_ / BM; nwg = nM * nN; G = G_; c = c_; }
    __host__ __device__ bool next(int i, Unit& u) const {
        const long L = (long)i * G + c; if (L >= nwg) return false;
        int wgid = (int)L; { const int q = nwg / NXCD, r = nwg % NXCD, xcd = wgid % NXCD, off = wgid / NXCD; wgid = (xcd < r ? xcd * (q + 1) : r * (q + 1) + (xcd - r) * q) + off; }
        const int nig = WGM * nN, gid = wgid / nig, fm = gid * WGM, gsz = (nM - fm) < WGM ? (nM - fm) : WGM;
        u.pm = fm + ((wgid % nig) % gsz); u.pn = (wgid % nig) / gsz; return true;
    }
};
template <class Epi, class Sched>
__device__ __forceinline__ void gemm_phase(PG8_LAS unsigned char* lds, const Gemm g, const Sched& S, const Epi& E) {
    const int tid = threadIdx.x, wid = __builtin_amdgcn_readfirstlane(tid >> 6), lane = tid & 63, wr = wid >> 2, wc = wid & 3, fr = lane & 15, fq = lane >> 4;
    const int K = g.K, nt = K / BK;
    unsigned voffA[2], voffB[2];
#pragma unroll
    for (int i = 0; i < 2; ++i) { int R, C; stage_rc(tid * 16 + i * 8192, R, C); const int Rb = (R & ~31) + perm32(R & 31);
        voffA[i] = (unsigned)(R * g.lda + C) * 2u; voffB[i] = (unsigned)(Rb * g.ldb + C) * 2u; }
    const size_t kstep = (size_t)(BK * 2);
    const size_t hstepA = (size_t)HALF * g.lda * 2, hstepB = (size_t)HALF * g.ldb * 2;
    const size_t tstepA = 2 * hstepA, tstepB = 2 * hstepB;
    const unsigned ldsw = (unsigned)wid * 1024u;
    const int aoff = lds_byte(wr * 64 + fr, fq * 8), boff = lds_byte(wc * 32 + fr, fq * 8);
#define PG8_SA(b, h) (((b) * 2 + (h)) * HTB)
#define PG8_SB(b, h) ((4 + (b) * 2 + (h)) * HTB)
#define PG8_STAGE(bufoff, gbase, voff) do { _Pragma("unroll") for (int _i = 0; _i < 2; ++_i) \
        __builtin_amdgcn_global_load_lds((const unsigned*)((const char*)(gbase) + (voff)[_i]), (PG8_LAS unsigned*)(lds + (bufoff) + ldsw + _i * 8192), 16, 0, 0); } while (0)
#define PG8_LDA(dst, b, h) do { _Pragma("unroll") for (int m = 0; m < 4; ++m) _Pragma("unroll") for (int k = 0; k < 2; ++k) dst[m][k] = *(const PG8_LAS bf16x8*)(lds + PG8_SA(b, h) + aoff + m * 2048 + k * 1024); } while (0)
#define PG8_LDB(dst, b, h) do { _Pragma("unroll") for (int n = 0; n < 2; ++n) _Pragma("unroll") for (int k = 0; k < 2; ++k) dst[n][k] = *(const PG8_LAS bf16x8*)(lds + PG8_SB(b, h) + boff + n * 2048 + k * 1024); } while (0)
#define PG8_MMA(ai, bj, At, Bt) do { __builtin_amdgcn_s_setprio(1); _Pragma("unroll") for (int m = 0; m < 4; ++m) _Pragma("unroll") for (int n = 0; n < 2; ++n) _Pragma("unroll") for (int k = 0; k < 2; ++k) \
        acc[ai][bj][m][n] = __builtin_amdgcn_mfma_f32_16x16x32_bf16(Bt[n][k], At[m][k], acc[ai][bj][m][n], 0, 0, 0); __builtin_amdgcn_s_setprio(0); } while (0)
#define PG8_WAIT_V(n) asm volatile("s_waitcnt vmcnt(" #n ")" ::: "memory")
#define PG8_WAIT_L(n) asm volatile("s_waitcnt lgkmcnt(" #n ")" ::: "memory")
#define PG8_BAR __builtin_amdgcn_s_barrier()
#define PG8_SCHED __builtin_amdgcn_sched_barrier(0)
    Unit cur, nxt; int ui = 0;
    if (!S.next(0, cur)) return;
    f32x4 acc[2][2][4][2];
#pragma unroll
    for (int a = 0; a < 2; ++a)
#pragma unroll
        for (int b = 0; b < 2; ++b)
#pragma unroll
            for (int m = 0; m < 4; ++m)
#pragma unroll
                for (int n = 0; n < 2; ++n) acc[a][b][m][n] = (f32x4){0.f, 0.f, 0.f, 0.f};
    bf16x8 At[4][2], B0[2][2], B1[2][2];
    const char* cA = (const char*)g.A + (size_t)cur.pm * tstepA; const char* cB = (const char*)g.Bt + (size_t)cur.pn * tstepB;
    PG8_STAGE(PG8_SB(0, 0), cB, voffB); PG8_STAGE(PG8_SB(0, 1), cB + hstepB, voffB); PG8_STAGE(PG8_SA(0, 0), cA, voffA); PG8_STAGE(PG8_SA(0, 1), cA + hstepA, voffA);
    if (wr == 1) PG8_BAR;
    PG8_WAIT_V(2); PG8_BAR;
    PG8_STAGE(PG8_SB(1, 0), cB + kstep, voffB); PG8_STAGE(PG8_SA(1, 0), cA + kstep, voffA); PG8_STAGE(PG8_SB(1, 1), cB + hstepB + kstep, voffB);
    PG8_WAIT_V(6); PG8_BAR;
    if constexpr (Epi::HAS_INIT) E.init(acc, cur, wr, wc, fr, fq);
    for (;;) {
        const bool has_next = S.next(ui + 1, nxt);
        const char* nA = has_next ? (const char*)g.A + (size_t)nxt.pm * tstepA : cA; const char* nB = has_next ? (const char*)g.Bt + (size_t)nxt.pn * tstepB : cB;
#pragma unroll 1
        for (int t = 0; t < nt; t += 2) {
            if constexpr (Epi::HAS_MID) { if (t == (nt >> 1)) { E.mid(acc, cur, wr, wc, fr, fq); PG8_SCHED; } }
            const bool last = (t == nt - 2);
            const char* a1 = cA + (size_t)(t + 1) * kstep;
            const char* a2 = last ? nA : cA + (size_t)(t + 2) * kstep; const char* b2 = last ? nB : cB + (size_t)(t + 2) * kstep;
            const char* a3 = a2 + kstep; const char* b3 = b2 + kstep;
            PG8_LDB(B0, 0, 0); PG8_LDB(B1, 0, 1); PG8_SCHED; PG8_LDA(At, 0, 0); PG8_STAGE(PG8_SA(1, 1), a1 + hstepA, voffA);
            PG8_WAIT_V(8); PG8_WAIT_L(0); PG8_BAR; PG8_MMA(0, 0, At, B0); PG8_MMA(0, 1, At, B1); PG8_BAR; PG8_SCHED;
            PG8_LDA(At, 0, 1); PG8_STAGE(PG8_SB(0, 0), b2, voffB); PG8_STAGE(PG8_SB(0, 1), b2 + hstepB, voffB); PG8_STAGE(PG8_SA(0, 0), a2, voffA);
            PG8_WAIT_V(8); PG8_WAIT_L(0); PG8_BAR; PG8_MMA(1, 0, At, B0); PG8_MMA(1, 1, At, B1); PG8_BAR; PG8_SCHED;
            PG8_LDB(B0, 1, 0); PG8_LDB(B1, 1, 1); PG8_SCHED; PG8_LDA(At, 1, 0); PG8_STAGE(PG8_SA(0, 1), a2 + hstepA, voffA);
            PG8_WAIT_V(8); PG8_WAIT_L(0); PG8_BAR; PG8_MMA(0, 0, At, B0); PG8_MMA(0, 1, At, B1); PG8_BAR; PG8_SCHED;
            PG8_LDA(At, 1, 1); PG8_STAGE(PG8_SB(1, 0), b3, voffB); PG8_STAGE(PG8_SB(1, 1), b3 + hstepB, voffB); PG8_STAGE(PG8_SA(1, 0), a3, voffA);
            PG8_WAIT_V(8); PG8_WAIT_L(0); PG8_BAR; PG8_MMA(1, 0, At, B0); PG8_MMA(1, 1, At, B1); PG8_BAR; PG8_SCHED;
        }
        if (wr == 0) PG8_BAR;
        if constexpr (Epi::HAS_PREP) { E.prep(cur, lds + STAGE_BYTES + 1024, tid); PG8_WAIT_L(0); PG8_BAR; }
        if constexpr (Epi::FINAL) E.fused(acc, cur, wr, wc, fr, fq, lds + STAGE_BYTES + 1024, tid);
        else E(acc, cur, wr, wc, fr, fq, lds + STAGE_BYTES + 1024);
        if (!has_next) break;
#pragma unroll
        for (int a = 0; a < 2; ++a)
#pragma unroll
            for (int b = 0; b < 2; ++b)
#pragma unroll
                for (int m = 0; m < 4; ++m)
#pragma unroll
                    for (int n = 0; n < 2; ++n) acc[a][b][m][n] = (f32x4){0.f, 0.f, 0.f, 0.f};
        cur = nxt; cA = nA; cB = nB; ++ui;
        if constexpr (Epi::HAS_INIT) E.init(acc, cur, wr, wc, fr, fq);
        if (wr == 1) PG8_BAR;
    }
    PG8_WAIT_V(0);
    PG8_BAR;
#undef PG8_SA
#undef PG8_SB
#undef PG8_STAGE
#undef PG8_LDA
#undef PG8_LDB
#undef PG8_MMA
#undef PG8_WAIT_V
#undef PG8_WAIT_L
#undef PG8_BAR
#undef PG8_SCHED
}
}

#define EPI_ROWS_BEGIN  _Pragma("unroll") for (int ai = 0; ai < 2; ++ai) _Pragma("unroll") for (int m = 0; m < 4; ++m) { const int row = row0 + ai * 128 + m * 16;
#define EPI_ROWS_END    asm volatile("" ::: "memory"); }
#define EPI_HALF_BEGIN  _Pragma("unroll") for (int ai = 0; ai < 2; ++ai) {
#define EPI_HALF_END    asm volatile("" ::: "memory"); }
#define EPI_M_LOOP      _Pragma("unroll") for (int m = 0; m < 4; ++m) { const int row = row0 + ai * 128 + m * 16;
__device__ __forceinline__ u32x4 pack8(f32x4 v0, f32x4 v1) { u32x4 w; w.x = pk2(v0[0], v0[1]); w.y = pk2(v0[2], v0[3]); w.z = pk2(v1[0], v1[1]); w.w = pk2(v1[2], v1[3]); return w; }
__device__ __forceinline__ void unpack8(u32x4 w, f32x4& v0, f32x4& v1) { v0 = (f32x4){bflo(w.x), bfhi(w.x), bflo(w.y), bfhi(w.y)}; v1 = (f32x4){bflo(w.z), bfhi(w.z), bflo(w.w), bfhi(w.w)}; }
typedef f32x4 acc_t[2][2][4][2];
__device__ __forceinline__ void st8wt(void* p, u32x2 v) { asm volatile("global_store_dwordx2 %0, %1, off sc1" :: "v"(p), "v"(v) : "memory"); }
__device__ __forceinline__ void st16wt(void* p, u32x4 v) { asm volatile("global_store_dwordx4 %0, %1, off sc1\n\ts_nop 2" :: "v"(p), "v"(v) : "memory"); }

struct EpiIn {
    static constexpr bool HAS_PREP = false, FINAL = false, HAS_MID = false, HAS_INIT = false;
    bf16_t *H0, *HQK, *HVO, *HG; float* SSQ; float* G32;
    __device__ __forceinline__ void operator()(const acc_t& acc, const pg8::Unit& u, int wr, int wc, int fr, int fq, LAS unsigned char* tab) const {
        bf16_t* base; int ld, ct; const int pn = u.pn;
        if (pn < 3) { base = H0; ld = 768; ct = pn * 256; }
        else if (pn < 7) { base = HQK; ld = 1024; ct = (pn - 3) * 256; }
        else if (pn < 11) { base = HVO; ld = 1024; ct = (pn - 7) * 256; }
        else { base = HG; ld = 2048; ct = (pn - 11) * 256; }
        const int row0 = u.pm * 256 + wr * 64 + fr, col0 = ct + wc * 32 + 8 * fq;
        EPI_ROWS_BEGIN
            bf16_t* rp = base + (size_t)row * ld + col0;
#pragma unroll
            for (int bj = 0; bj < 2; ++bj) {
                const f32x4 v0 = acc[ai][bj][m][0], v1 = acc[ai][bj][m][1];
                *(u32x4*)(rp + bj * 128) = pack8(v0, v1);
                if (pn < 3) {
                    float s = dot4(v0) + dot4(v1); s += __shfl_xor(s, 16); s += __shfl_xor(s, 32);
                    if (fq == 0 && !(pn == 2 && bj == 1)) SSQ[(size_t)((pn * 2 + bj) * 4 + wc) * M + row] = s;
                    if (pn == 2 && bj == 1 && wc == 1 && fq < 2) { float* gp = G32 + (size_t)row * 16 + 8 * fq; *(f32x4*)gp = v0; *(f32x4*)(gp + 4) = v1; }
                }
            }
        EPI_ROWS_END
    }
};
struct EpiQ {
    static constexpr bool HAS_PREP = true, FINAL = false, HAS_MID = false, HAS_INIT = false;
    bf16_t* Q; const float* SSQ; const float* ROPE;
    __device__ __forceinline__ void prep(const pg8::Unit& u, LAS unsigned char* tab, int tid) const {
        if (tid < 256) { const int row = u.pm * 256 + tid; float ss = 0.f;
#pragma unroll
            for (int p = 0; p < 12; ++p) ss += SSQ[(size_t)p * M + row];
            ((LAS float*)tab)[tid] = rsqrtf(ss * (1.f / 384.f) + NORM_EPS) * (0.10206207261596575f * 1.4426950408889634f); }
    }
    __device__ __forceinline__ void operator()(const acc_t& acc, const pg8::Unit& u, int wr, int wc, int fr, int fq, LAS unsigned char* tab) const {
        const int row0 = u.pm * 256 + wr * 64 + fr, col0 = u.pn * 256 + wc * 32 + 8 * fq;
        EPI_HALF_BEGIN
            f32x4 rc[4][2], rs[4][2];
            EPI_M_LOOP
#pragma unroll
                for (int bj = 0; bj < 2; ++bj) { const int d = (col0 + bj * 128) % 96; rc[m][bj] = f32x4{}; rs[m][bj] = f32x4{};
                    if (d >= 64) { const int j0 = (d - 64) >> 1; rc[m][bj] = *(const f32x4*)(ROPE + (size_t)row * 32 + j0); rs[m][bj] = *(const f32x4*)(ROPE + (size_t)row * 32 + 16 + j0); } } }
            EPI_M_LOOP
                const float rstd = ((const LAS float*)tab)[row - u.pm * 256];
#pragma unroll
                for (int bj = 0; bj < 2; ++bj) {
                    const int col = col0 + bj * 128, d = col % 96;
                    f32x4 v0 = acc[ai][bj][m][0] * rstd, v1 = acc[ai][bj][m][1] * rstd;
                    if (d >= 64) { const f32x4 c = rc[m][bj], s = rs[m][bj]; const f32x4 o0 = v0 * c - v1 * s, o1 = v1 * c + v0 * s; v0 = o0; v1 = o1; }
                    *(u32x4*)(Q + (size_t)row * 768 + col) = pack8(v0, v1);
                } }
        EPI_HALF_END
    }
};
struct EpiKV {
    static constexpr bool HAS_PREP = true, FINAL = false, HAS_MID = false, HAS_INIT = false;
    bf16_t* KV; const float* SSQ;
    __device__ __forceinline__ void prep(const pg8::Unit& u, LAS unsigned char* tab, int tid) const {
        if (tid < 256) { const int row = u.pm * 256 + tid; float ss = 0.f;
#pragma unroll
            for (int p = 12; p < 20; ++p) ss += SSQ[(size_t)p * M + row];
            ((LAS float*)tab)[tid] = rsqrtf(ss * (1.f / 256.f) + NORM_EPS); }
    }
    __device__ __forceinline__ void operator()(const acc_t& acc, const pg8::Unit& u, int wr, int wc, int fr, int fq, LAS unsigned char* tab) const {
        const int row0 = u.pm * 256 + wr * 64 + fr, col0 = u.pn * 256 + wc * 32 + 8 * fq;
        EPI_ROWS_BEGIN
            const float rstd = ((const LAS float*)tab)[row - u.pm * 256];
#pragma unroll
            for (int bj = 0; bj < 2; ++bj) {
                const int col = col0 + bj * 128;
                *(u32x4*)(KV + (size_t)row * 1024 + col) = pack8(acc[ai][bj][m][0] * rstd, acc[ai][bj][m][1] * rstd);
            }
        EPI_ROWS_END
    }
};
struct EpiMergeF {
    static constexpr bool HAS_PREP = false, FINAL = false, HAS_MID = true, HAS_INIT = false;
    bf16_t* MG; const bf16_t* HG;
    __device__ __forceinline__ void mid(acc_t& acc, const pg8::Unit& u, int wr, int wc, int fr, int fq) const {
        int lane_ = threadIdx.x & 63; asm volatile("" : "+v"(lane_));
        const int row0 = u.pm * 256 + wr * 64 + (lane_ & 15), col0 = u.pn * 256 + wc * 32 + 8 * (lane_ >> 4);
#pragma unroll
        for (int ai = 0; ai < 2; ++ai)
#pragma unroll
            for (int mp = 0; mp < 2; ++mp) {
                u32x4 ga[2][2], gb[2][2];
#pragma unroll
                for (int mm = 0; mm < 2; ++mm) { const int row = row0 + ai * 128 + (2 * mp + mm) * 16;
#pragma unroll
                    for (int bj = 0; bj < 2; ++bj) { ga[mm][bj] = __builtin_nontemporal_load((const u32x4*)(HG + (size_t)row * 2048 + col0 + bj * 128)); gb[mm][bj] = *(const u32x4*)(HG + (size_t)row * 2048 + 1024 + col0 + bj * 128); } }
#pragma unroll
                for (int mm = 0; mm < 2; ++mm) { const int m = 2 * mp + mm;
#pragma unroll
                    for (int bj = 0; bj < 2; ++bj) { f32x4 a0, a1, b0, b1; unpack8(ga[mm][bj], a0, a1); unpack8(gb[mm][bj], b0, b1);
#pragma unroll
                        for (int e = 0; e < 4; ++e) {
                            acc[ai][bj][m][0][e] *= (1.f + __expf(fminf(-b0[e], 60.f))) * __builtin_amdgcn_rcpf(1.f + __expf(fminf(-a0[e], 60.f)));
                            acc[ai][bj][m][1][e] *= (1.f + __expf(fminf(-b1[e], 60.f))) * __builtin_amdgcn_rcpf(1.f + __expf(fminf(-a1[e], 60.f))); } } }
                asm volatile("" ::: "memory");
            }
    }
    __device__ __forceinline__ void operator()(const acc_t& acc, const pg8::Unit& u, int wr, int wc, int fr, int fq, LAS unsigned char* tab) const {
        const int row0 = u.pm * 256 + wr * 64 + fr, col0 = u.pn * 256 + wc * 32 + 8 * fq;
        EPI_HALF_BEGIN
            u32x4 gb[4][2];
            EPI_M_LOOP
#pragma unroll
                for (int bj = 0; bj < 2; ++bj) gb[m][bj] = __builtin_nontemporal_load((const u32x4*)(HG + (size_t)row * 2048 + 1024 + col0 + bj * 128)); }
            EPI_M_LOOP
#pragma unroll
                for (int bj = 0; bj < 2; ++bj) { f32x4 b0, b1; unpack8(gb[m][bj], b0, b1);
                    f32x4 v0 = acc[ai][bj][m][0], v1 = acc[ai][bj][m][1];
#pragma unroll
                    for (int e = 0; e < 4; ++e) { v0[e] *= __builtin_amdgcn_rcpf(1.f + __expf(fminf(-b0[e], 60.f))); v1[e] *= __builtin_amdgcn_rcpf(1.f + __expf(fminf(-b1[e], 60.f))); }
                    *(u32x4*)(MG + (size_t)row * 1024 + col0 + bj * 128) = pack8(v0, v1);
                } }
        EPI_HALF_END
    }
};
struct EpiRes {
    static constexpr bool HAS_PREP = false, FINAL = false, HAS_MID = false, HAS_INIT = true;
    const float* X; float* Y; bf16_t* YB; float* SSQ; bool early;
    __device__ __forceinline__ void init(acc_t& acc, const pg8::Unit& u, int wr, int wc, int fr, int fq) const {
        if (!early) return;
        int lane_ = threadIdx.x & 63; asm volatile("" : "+v"(lane_));
        const int row0 = u.pm * 256 + wr * 64 + (lane_ & 15), col0 = u.pn * 256 + wc * 32 + 8 * (lane_ >> 4);
#pragma unroll
        for (int ai = 0; ai < 2; ++ai)
#pragma unroll
            for (int m = 0; m < 4; ++m) { const int row = row0 + ai * 128 + m * 16;
#pragma unroll
                for (int bj = 0; bj < 2; ++bj) { const size_t off = (size_t)row * 1024 + col0 + bj * 128;
                    acc[ai][bj][m][0] = __builtin_nontemporal_load((const f32x4*)(X + off)); acc[ai][bj][m][1] = __builtin_nontemporal_load((const f32x4*)(X + off + 4)); } }
    }
    __device__ __forceinline__ void operator()(const acc_t& acc, const pg8::Unit& u, int wr, int wc, int fr, int fq, LAS unsigned char* tab) const {
        const int row0 = u.pm * 256 + wr * 64 + fr, col0 = u.pn * 256 + wc * 32 + 8 * fq;
        EPI_HALF_BEGIN
            f32x4 xa[4][2][2];
            EPI_M_LOOP
#pragma unroll
                for (int bj = 0; bj < 2; ++bj) { const size_t off = (size_t)row * 1024 + col0 + bj * 128; xa[m][bj][0] = f32x4{}; xa[m][bj][1] = f32x4{};
                    if (!early) { xa[m][bj][0] = __builtin_nontemporal_load((const f32x4*)(X + off)); xa[m][bj][1] = __builtin_nontemporal_load((const f32x4*)(X + off + 4)); } } }
            EPI_M_LOOP
                float s = 0.f;
#pragma unroll
                for (int bj = 0; bj < 2; ++bj) {
                    const size_t off = (size_t)row * 1024 + col0 + bj * 128;
                    const f32x4 v0 = xa[m][bj][0] + acc[ai][bj][m][0], v1 = xa[m][bj][1] + acc[ai][bj][m][1];
                    if (Y) { *(f32x4*)(Y + off) = v0; *(f32x4*)(Y + off + 4) = v1; }
                    if (YB) *(u32x4*)(YB + off) = pack8(v0, v1);
                    s += dot4(v0) + dot4(v1);
                }
                s += __shfl_xor(s, 16); s += __shfl_xor(s, 32);
                if (fq == 0) SSQ[(size_t)(u.pn * 4 + wc) * M + row] = s; }
        EPI_HALF_END
    }
};
struct EpiUp {
    static constexpr bool HAS_PREP = true, FINAL = false, HAS_MID = false, HAS_INIT = false;
    bf16_t* ACT; const float* SSQ1;
    __device__ __forceinline__ void prep(const pg8::Unit& u, LAS unsigned char* tab, int tid) const {
        if (tid < 256) { const int row = u.pm * 256 + tid; float ss = 0.f;
#pragma unroll
            for (int p = 0; p < 16; ++p) ss += SSQ1[(size_t)p * M + row];
            ((LAS float*)tab)[tid] = rsqrtf(ss * (1.f / 1024.f) + NORM_EPS); }
    }
    __device__ __forceinline__ void operator()(const acc_t& acc, const pg8::Unit& u, int wr, int wc, int fr, int fq, LAS unsigned char* tab) const {
        const int row0 = u.pm * 256 + wr * 64 + fr, col0 = u.pn * 256 + wc * 32 + 8 * fq;
        EPI_ROWS_BEGIN
            const float rstd = ((const LAS float*)tab)[row - u.pm * 256];
#pragma unroll
            for (int bj = 0; bj < 2; ++bj) {
                f32x4 v0 = acc[ai][bj][m][0] * rstd, v1 = acc[ai][bj][m][1] * rstd;
#pragma unroll
                for (int e = 0; e < 4; ++e) { const float a = fmaxf(v0[e], 0.f), b = fmaxf(v1[e], 0.f); v0[e] = a * a; v1[e] = b * b; }
                st16wt(ACT + (size_t)row * DFF + col0 + bj * 128, pack8(v0, v1));
            }
        EPI_ROWS_END
    }
};

struct EpiFinal {
    static constexpr bool HAS_PREP = false, FINAL = true, HAS_MID = false, HAS_INIT = false;
    const bf16_t* XB; float* Y; const float* gfin; float* SLAB; unsigned* cnt;
    __device__ __forceinline__ void operator()(const acc_t&, const pg8::Unit&, int, int, int, int, LAS unsigned char*) const {}
    __device__ __forceinline__ void fused(acc_t& acc, const pg8::Unit& u, int wr, int wc, int fr, int fq, LAS unsigned char* tab, int tid) const {
        LAS float* PT = (LAS float*)tab;
        LAS float* RS = PT + 1024;
        const int row0 = u.pm * 256 + wr * 64 + fr, col0 = u.pn * 256 + wc * 32 + 8 * fq;
        EPI_HALF_BEGIN
            u32x4 xb[4][2];
            EPI_M_LOOP
#pragma unroll
                for (int bj = 0; bj < 2; ++bj) xb[m][bj] = __builtin_nontemporal_load((const u32x4*)(XB + (size_t)row * 1024 + col0 + bj * 128)); }
            EPI_M_LOOP
                float s = 0.f;
#pragma unroll
                for (int bj = 0; bj < 2; ++bj) {
                    { f32x4 x0, x1; unpack8(xb[m][bj], x0, x1); acc[ai][bj][m][0] += x0; acc[ai][bj][m][1] += x1; }
                    s += dot4(acc[ai][bj][m][0]) + dot4(acc[ai][bj][m][1]);
                }
                s += __shfl_xor(s, 16); s += __shfl_xor(s, 32);
                if (fq == 0) PT[(row - u.pm * 256) * 4 + wc] = s; }
        EPI_HALF_END
        asm volatile("s_waitcnt lgkmcnt(0)" ::: "memory"); __builtin_amdgcn_s_barrier(); asm volatile("" ::: "memory");
        if (tid < 256) { const f32x4 p = *(const LAS f32x4*)(PT + tid * 4);
            __hip_atomic_store(SLAB + (size_t)u.pn * M + u.pm * 256 + tid, (p[0] + p[1]) + (p[2] + p[3]), __ATOMIC_RELAXED, __HIP_MEMORY_SCOPE_AGENT); }
        asm volatile("s_waitcnt vmcnt(0)" ::: "memory"); __builtin_amdgcn_s_barrier(); asm volatile("" ::: "memory");
        if (tid == 0) __hip_atomic_fetch_add(cnt + 64 * u.pm, 1u, __ATOMIC_RELAXED, __HIP_MEMORY_SCOPE_AGENT);
        if (tid < 64) { unsigned spins = 0;
            while (__hip_atomic_load(cnt + 64 * u.pm, __ATOMIC_RELAXED, __HIP_MEMORY_SCOPE_AGENT) < 4u) { __builtin_amdgcn_s_sleep(2); if (++spins > (1u << 20)) break; }
            __builtin_amdgcn_fence(__ATOMIC_ACQUIRE, "agent"); asm volatile("s_waitcnt vmcnt(0)" ::: "memory"); }
        __builtin_amdgcn_s_barrier(); asm volatile("" ::: "memory");
        if (tid < 256) { float ss = 0.f;
#pragma unroll
            for (int t = 0; t < 4; ++t) ss += __hip_atomic_load(SLAB + (size_t)t * M + u.pm * 256 + tid, __ATOMIC_RELAXED, __HIP_MEMORY_SCOPE_AGENT);
            RS[tid] = rsqrtf(ss * (1.f / 1024.f) + NORM_EPS); }
        asm volatile("s_waitcnt lgkmcnt(0)" ::: "memory"); __builtin_amdgcn_s_barrier(); asm volatile("" ::: "memory");
        f32x4 gf[2][2];
#pragma unroll
        for (int bj = 0; bj < 2; ++bj) { gf[bj][0] = *(const f32x4*)(gfin + col0 + bj * 128); gf[bj][1] = *(const f32x4*)(gfin + col0 + bj * 128 + 4); }
        EPI_ROWS_BEGIN
            const float rstd = RS[row - u.pm * 256];
#pragma unroll
            for (int bj = 0; bj < 2; ++bj) {
                const size_t off = (size_t)row * 1024 + col0 + bj * 128;
                *(f32x4*)(Y + off) = acc[ai][bj][m][0] * rstd * gf[bj][0]; *(f32x4*)(Y + off + 4) = acc[ai][bj][m][1] * rstd * gf[bj][1];
            }
        EPI_ROWS_END
    }
};

namespace att {
constexpr int NW = 8, QBLK = 32, KVBLK = 64;
constexpr float QSCALE = 0.10206207261596575f * 1.4426950408889634f;
constexpr float THRL = 8.f;
constexpr int LDQ = 768, LDKV = 1024, LDKR = 32, LDO = 1024;
constexpr int SLOTB = 12288, LDS_K = 0, LDS_V = 3 * SLOTB, SHM_ATTN = 6 * SLOTB;
#define SBAR() __builtin_amdgcn_sched_barrier(0)
#define WAIT_BAR(N) asm volatile("s_waitcnt vmcnt(" #N ") lgkmcnt(0)\n\ts_barrier" ::: "memory")
__device__ __forceinline__ void glds16(const void* gsrc, unsigned lds_dst) { unsigned keep;
  asm volatile("s_mov_b32 %0, m0\n\ts_mov_b32 m0, %2\n\ts_nop 0\n\tglobal_load_lds_dwordx4 %1, off\n\ts_mov_b32 m0, %0" : "=&s"(keep) : "v"(gsrc), "s"(lds_dst) : "memory"); }
typedef LAS const char* lds_cptr;
typedef short v4i16_t __attribute__((ext_vector_type(4)));
__device__ __forceinline__ void kload2(bf16x8* kf, lds_cptr kp, int j) { kf[2 * j] = *(const LAS bf16x8*)(kp + j * 2048); kf[2 * j + 1] = *(const LAS bf16x8*)(kp + j * 2048 + 512); }
__device__ __forceinline__ s16x4 vtr(lds_cptr p) { return __builtin_bit_cast(s16x4, __builtin_amdgcn_ds_read_tr16_b64_v4i16((LAS v4i16_t*)p)); }
__device__ __forceinline__ unsigned cvtpk_s(float lo, float hi) { typedef float f2_t __attribute__((ext_vector_type(2))); typedef __bf16 b2_t __attribute__((ext_vector_type(2)));
  f2_t v = {lo, hi}; b2_t b = __builtin_convertvector(v, b2_t); return __builtin_bit_cast(unsigned, b); }
#define MX3(a, b, c) __builtin_fmaxf(__builtin_fmaxf((a), (b)), (c))
__device__ __forceinline__ float rowmax(const f32x16& p0, const f32x16& p1) {
  float a = MX3(p0[0], p0[1], p1[0]), b = MX3(p0[2], p0[3], p1[1]); a = MX3(a, p1[2], p1[3]);
#pragma unroll
  for (int r = 4; r < 16; r += 4) { a = MX3(a, p0[r], p0[r + 1]); b = MX3(b, p0[r + 2], p0[r + 3]); a = MX3(a, p1[r], p1[r + 1]); b = MX3(b, p1[r + 2], p1[r + 3]); }
  float m = __builtin_fmaxf(a, b); auto rr = __builtin_amdgcn_permlane32_swap(__float_as_uint(m), __float_as_uint(m), false, false);
  return __builtin_fmaxf(__uint_as_float(rr[0]), __uint_as_float(rr[1])); }
#define MFMA(a, b, c) __builtin_amdgcn_mfma_f32_32x32x16_bf16(a, b, c, 0, 0, 0)
__device__ __forceinline__ void attn_unit(const bf16_t* __restrict__ Qb, const bf16_t* __restrict__ Kh, const bf16_t* __restrict__ KRb, bf16_t* __restrict__ Ob, LAS unsigned char* shm) {
  int tid = threadIdx.x; asm volatile("" : "+v"(tid));
  const int lane = tid & 63, r32 = lane & 31, hi = lane >> 5; const int wid = __builtin_amdgcn_readfirstlane(tid >> 6);
  const bool w3 = wid < 4;
  const unsigned lds0 = (unsigned)(uintptr_t)shm;
  const bf16_t* ksrc = Kh + (long)lane * LDKV + wid * 8;
  const bf16_t* rsrc = KRb + (long)lane * LDKR + (wid & 3) * 8;
  const bf16_t* vsrc = Kh + 64 + (long)(16 * (wid & 3) + (lane >> 2)) * LDKV + (wid >> 2) * 32 + (lane & 3) * 8;
  const unsigned kdst = lds0 + LDS_K + wid * 1024, rdst = lds0 + LDS_K + (8 + (wid & 3)) * 1024, vdst = lds0 + LDS_V + wid * 1024;
#define DMA_K(t, slot) do { glds16(ksrc + (long)(t) * KVBLK * LDKV, (unsigned)__builtin_amdgcn_readfirstlane(kdst + (slot))); \
    if (w3) glds16(rsrc + (long)(t) * KVBLK * LDKR, (unsigned)__builtin_amdgcn_readfirstlane(rdst + (slot))); } while (0)
#define DMA_V(t, slot) glds16(vsrc + (long)(t) * KVBLK * LDKV, (unsigned)__builtin_amdgcn_readfirstlane(vdst + (slot)))
#define WAITB(NHI, NLO) do { if (w3) { WAIT_BAR(NHI); } else { WAIT_BAR(NLO); } } while (0)
  const lds_cptr shm3 = (lds_cptr)shm; const lds_cptr kp0 = shm3 + LDS_K + hi * 1024 + r32 * 16;
  const lds_cptr vp0 = shm3 + LDS_V + ((lane >> 4) & 1) * 32 + (lane & 3) * 8 + (4 * hi + ((lane & 15) >> 2)) * 64;
  constexpr int NT = SEQ / KVBLK;
  DMA_K(0, 0); DMA_V(0, 0); DMA_K(1, SLOTB);
  bf16x8 qr[6]; bf16x8 kf[12];
  { const bf16_t* Qw = Qb + (long)(wid * QBLK + r32) * LDQ + hi * 8;
#pragma unroll
    for (int d0 = 0; d0 < 6; ++d0) qr[d0] = *reinterpret_cast<const bf16x8*>(Qw + d0 * 16); }
  float mhat = 0.f, l_reg = 0.f, fres = 1.f; f32x16 o[2]; o[0] = f32x16{}; o[1] = f32x16{}; f32x16 negm = f32x16{}; asm volatile("" : "+v"(negm));
  bool resc = false;
#define RESC() do { if (resc) { _Pragma("unroll") for (int d_ = 0; d_ < 2; ++d_) _Pragma("unroll") for (int r = 0; r < 16; ++r) o[d_][r] *= fres; } } while (0)
  f32x16 pA0, pA1, pB0, pB1;
  int sl_prev = 0, sl_cur = 0, sl_next = SLOTB;
#define ROT() do { sl_prev = sl_cur; sl_cur = sl_next; sl_next = (sl_next == 2 * SLOTB) ? 0 : sl_next + SLOTB; } while (0)
  DMA_K(2, 2 * SLOTB);
  WAITB(5, 3);
#pragma unroll
  for (int j = 0; j < 6; ++j) kload2(kf, kp0, j);
#pragma unroll
  for (int j = 0; j < 6; ++j) { pA0 = MFMA(kf[2 * j], qr[j], j ? pA0 : negm); pA1 = MFMA(kf[2 * j + 1], qr[j], j ? pA1 : negm); }
  { const float rm = rowmax(pA0, pA1); mhat = rm;
#pragma unroll
    for (int r = 0; r < 16; ++r) { pA0[r] = __builtin_amdgcn_exp2f(pA0[r] - rm); pA1[r] = __builtin_amdgcn_exp2f(pA1[r] - rm); }
#pragma unroll
    for (int r = 0; r < 16; ++r) negm[r] = -mhat;
    asm volatile("" : "+v"(negm)); }
  WAIT_BAR(0);
  DMA_K(3, 0); DMA_V(1, SLOTB);
  ROT();
#pragma unroll
  for (int j = 0; j < 6; ++j) kload2(kf, kp0 + sl_cur, j);
  WAITB(3, 2);
  s16x4 vlo[8], vhi[8]; u32x4 pw0, pw1, pw2, pw3;
#define PKW(P, B) cvtpk_s(P[B], P[(B) + 1])
#define PAF(k) __builtin_bit_cast(bf16x8, pw##k)
#define VFR(i) (bf16x8){vlo[i][0], vlo[i][1], vlo[i][2], vlo[i][3], vhi[i][0], vhi[i][1], vhi[i][2], vhi[i][3]}
#define PIN(x) asm volatile("" : "+v"(x))
#define EX(v) __builtin_amdgcn_exp2f(v)
#define VRD(i) do { vlo[i] = vtr(vp_ + (((i) >> 2) * 4096 + ((i) & 3) * 1024)); vhi[i] = vtr(vp_ + (((i) >> 2) * 4096 + ((i) & 3) * 1024 + 512)); } while (0)
#define KRD(G, j) do { if (G) { kload2(kf, kp0 + sl_next, j); SBAR(); } } while (0)
#define GA3(MF, A0, A1, A2, W0, PW) do { MF; sacc += A0; sacc += A1; sacc += A2; PIN(sacc); W0; PIN(PW); SBAR(); } while (0)
#define GA2(MF, A0, A1, W0, W1, PW) do { MF; sacc += A0; sacc += A1; PIN(sacc); W0; W1; PIN(PW); SBAR(); } while (0)
#define GA2S(MF, A0, A1, W0, PW) do { MF; sacc += A0; sacc += A1; PIN(sacc); W0; PIN(PW); SBAR(); } while (0)
#define GAPB(MF, X, B) do { MF; X[B] = EX(X[B]); X[(B) + 1] = EX(X[(B) + 1]); X[(B) + 2] = EX(X[(B) + 2]); X[(B) + 3] = EX(X[(B) + 3]); PIN(X); SBAR(); } while (0)
#define STEP(C0, C1, P0, P1, t, GK, GV, GL) do { SBAR(); \
    const lds_cptr vp_ = vp0 + sl_prev; \
    VRD(0); SBAR(); float sacc = (P0[0] + P0[1]); \
                    GA3(C0 = MFMA(kf[0], qr[0], negm),  P0[2], P0[3], P0[4],      pw0[0] = PKW(P0, 0), pw0); \
    VRD(4); SBAR(); GA3(C1 = MFMA(kf[1], qr[0], negm),  P0[5], P0[6], P0[7],      pw0[1] = PKW(P0, 2), pw0); \
                    GA2(C0 = MFMA(kf[2], qr[1], C0),    P0[8], P0[9],             pw0[2] = PKW(P0, 4), pw0[3] = PKW(P0, 6), pw0); \
    VRD(1); SBAR(); GA3(C1 = MFMA(kf[3], qr[1], C1),    P0[10], P0[11], P0[12],   pw1[0] = PKW(P0, 8), pw1); \
    VRD(5); SBAR(); GA3(C0 = MFMA(kf[4], qr[2], C0),    P0[13], P0[14], P0[15],   pw1[1] = PKW(P0, 10), pw1); \
                    GA2(C1 = MFMA(kf[5], qr[2], C1),    P1[0], P1[1],             pw1[2] = PKW(P0, 12), pw1[3] = PKW(P0, 14), pw1); \
    VRD(2); SBAR(); GA3(C0 = MFMA(kf[6], qr[3], C0),    P1[2], P1[3], P1[4],      pw2[0] = PKW(P1, 0), pw2); \
    VRD(6); SBAR(); GA3(C1 = MFMA(kf[7], qr[3], C1),    P1[5], P1[6], P1[7],      pw2[1] = PKW(P1, 2), pw2); \
                    GA2(C0 = MFMA(kf[8], qr[4], C0),    P1[8], P1[9],             pw2[2] = PKW(P1, 4), pw2[3] = PKW(P1, 6), pw2); \
    VRD(3); SBAR(); GA2S(C1 = MFMA(kf[9], qr[4], C1),   P1[10], P1[11],           pw3[0] = PKW(P1, 8), pw3); \
    VRD(7); SBAR(); GA2S(C0 = MFMA(kf[10], qr[5], C0),  P1[12], P1[13],           pw3[1] = PKW(P1, 10), pw3); \
                    GA2(C1 = MFMA(kf[11], qr[5], C1),   P1[14], P1[15],           pw3[2] = PKW(P1, 12), pw3[3] = PKW(P1, 14), pw3); \
    l_reg += sacc; \
    if (GK) { DMA_K((t) + 3, sl_cur); } if (GV) { DMA_V((t) + 1, sl_next); } \
    { const float rm = rowmax(C0, C1); resc = false; \
      if (__builtin_expect(__any(rm > THRL), 0)) { const float dl = __builtin_fmaxf(rm, 0.f); mhat += dl; \
        _Pragma("unroll") for (int r = 0; r < 16; ++r) { C0[r] -= dl; C1[r] -= dl; } \
        _Pragma("unroll") for (int r = 0; r < 16; ++r) negm[r] = -mhat; \
        asm volatile("" : "+v"(negm)); \
        fres = __builtin_amdgcn_exp2f(-dl); l_reg *= fres; resc = true; } } \
    SBAR(); \
                GAPB(o[0] = MFMA(VFR(0), PAF(0), o[0]), C0, 0); \
    KRD(GL, 0); GAPB(o[1] = MFMA(VFR(4), PAF(0), o[1]), C0, 4); \
    KRD(GL, 1); GAPB(o[0] = MFMA(VFR(1), PAF(1), o[0]), C0, 8); \
    KRD(GL, 2); GAPB(o[1] = MFMA(VFR(5), PAF(1), o[1]), C0, 12); \
    KRD(GL, 3); GAPB(o[0] = MFMA(VFR(2), PAF(2), o[0]), C1, 0); \
    KRD(GL, 4); GAPB(o[1] = MFMA(VFR(6), PAF(2), o[1]), C1, 4); \
    KRD(GL, 5); GAPB(o[0] = MFMA(VFR(3), PAF(3), o[0]), C1, 8); \
                GAPB(o[1] = MFMA(VFR(7), PAF(3), o[1]), C1, 12); \
    } while (0)
  int t = 1;
  for (; t + 5 < NT; t += 2) {
    STEP(pB0, pB1, pA0, pA1, t, true, true, true);     WAITB(3, 2); RESC(); ROT();
    STEP(pA0, pA1, pB0, pB1, t + 1, true, true, true); WAITB(3, 2); RESC(); ROT();
  }
#define ENDW(tt) do { if ((tt) + 3 < NT) { WAITB(3, 2); } else if ((tt) + 2 < NT) { WAIT_BAR(1); } else { WAIT_BAR(0); } } while (0)
  for (; t + 1 < NT; t += 2) {
    STEP(pB0, pB1, pA0, pA1, t, (t + 3 < NT), (t + 1 < NT), (t + 1 < NT));         ENDW(t);     RESC(); ROT();
    STEP(pA0, pA1, pB0, pB1, t + 1, (t + 4 < NT), (t + 2 < NT), (t + 2 < NT));     ENDW(t + 1); RESC(); ROT();
  }
  STEP(pB0, pB1, pA0, pA1, NT - 1, false, false, false); RESC();
  { float sacc = pB0[0] + pB0[1];
#pragma unroll
    for (int r = 2; r < 16; ++r) sacc += pB0[r];
#pragma unroll
    for (int r = 0; r < 16; ++r) sacc += pB1[r];
    l_reg += sacc;
    pw0 = (u32x4){PKW(pB0, 0), PKW(pB0, 2), PKW(pB0, 4), PKW(pB0, 6)}; pw1 = (u32x4){PKW(pB0, 8), PKW(pB0, 10), PKW(pB0, 12), PKW(pB0, 14)};
    pw2 = (u32x4){PKW(pB1, 0), PKW(pB1, 2), PKW(pB1, 4), PKW(pB1, 6)}; pw3 = (u32x4){PKW(pB1, 8), PKW(pB1, 10), PKW(pB1, 12), PKW(pB1, 14)};
    const lds_cptr vp_ = vp0 + sl_cur;
#pragma unroll
    for (int i = 0; i < 8; ++i) VRD(i);
    o[0] = MFMA(VFR(0), PAF(0), o[0]); o[1] = MFMA(VFR(4), PAF(0), o[1]); o[0] = MFMA(VFR(1), PAF(1), o[0]); o[1] = MFMA(VFR(5), PAF(1), o[1]);
    o[0] = MFMA(VFR(2), PAF(2), o[0]); o[1] = MFMA(VFR(6), PAF(2), o[1]); o[0] = MFMA(VFR(3), PAF(3), o[0]); o[1] = MFMA(VFR(7), PAF(3), o[1]); }
  { auto rr = __builtin_amdgcn_permlane32_swap(__float_as_uint(l_reg), __float_as_uint(l_reg), false, false); l_reg = __uint_as_float(rr[0]) + __uint_as_float(rr[1]); }
  const float rl = __builtin_amdgcn_rcpf(l_reg);
  bf16_t* Ow = Ob + (long)(wid * QBLK + r32) * LDO + 4 * hi;
#pragma unroll
  for (int d0 = 0; d0 < 2; ++d0)
#pragma unroll
    for (int i = 0; i < 4; ++i) { u32x2 w; w.x = pk2(o[d0][4 * i] * rl, o[d0][4 * i + 1] * rl); w.y = pk2(o[d0][4 * i + 2] * rl, o[d0][4 * i + 3] * rl); *(u32x2*)(Ow + d0 * 32 + 8 * i) = w; }
  asm volatile("s_waitcnt lgkmcnt(0)\n\ts_barrier" ::: "memory");
#undef DMA_K
#undef DMA_V
#undef WAITB
#undef RESC
#undef ROT
#undef PKW
#undef PAF
#undef VFR
#undef PIN
#undef EX
#undef VRD
#undef KRD
#undef GA3
#undef GA2
#undef GA2S
#undef GAPB
#undef STEP
#undef ENDW
}
#undef SBAR
#undef WAIT_BAR
#undef MX3
#undef MFMA
}

struct Ptrs {
    const float* x; const int* pos; const float *g_mix, *w_in, *g_q, *w_uq, *g_kv, *w_ukv, *conv_w, *conv_b, *ig_b, *fg_b, *g_on, *w_bm, *w_bl, *w_out, *g_mlp, *w_up, *w_dn, *g_fin;
    float* out; unsigned char* ws;
    bf16_t *WinT, *WuqT, *WukvT, *WbmT, *WblT, *WoutT, *WupT, *WdnT;
    float *ROPE, *SSQ, *SSQ1, *SSQ2, *G32, *UN, *BL, *ML, *MP;
    bf16_t *H0, *HQK, *HVO, *HG, *XN, *UC, *QC, *KC, *VTG, *G1, *MERGED, *X1B, *ACT, *YA, *YM, *Q, *KV, *KR;
};

__device__ __forceinline__ float logsig_(float x) { return fminf(x, 0.f) - log1pf(__expf(-fabsf(x))); }
__device__ __forceinline__ float wave_scan_add(float v, int lane) {
#pragma unroll
    for (int o = 1; o < 64; o <<= 1) { const float t = __shfl_up(v, o); if (lane >= o) v += t; }
    return v;
}
__device__ __forceinline__ float wave_scan_max(float v, int lane) {
#pragma unroll
    for (int o = 1; o < 64; o <<= 1) { const float t = __shfl_up(v, o); if (lane >= o) v = fmaxf(v, t); }
    return v;
}
__device__ __forceinline__ float wave_max(float v) {
#pragma unroll
    for (int o = 1; o < 64; o <<= 1) v = fmaxf(v, __shfl_xor(v, o));
    return v;
}
__device__ __forceinline__ f32x4 mfma16(bf16x8 a, bf16x8 b, f32x4 c) { return __builtin_amdgcn_mfma_f32_16x16x32_bf16(a, b, c, 0, 0, 0); }
__device__ __forceinline__ void conv_load(const bf16_t* __restrict__ HQK, long trow0, long seq_lo, long seq_hi, int ch, int tg, u32x4 (&xr)[6]) {
#pragma unroll
    for (int i = 0; i < 6; ++i) { const long r = trow0 + 2 * tg - 2 + i;
        const bool in = (r >= seq_lo && r < seq_hi); const long rc = in ? r : seq_lo; const u32x4 w = *(const u32x4*)(HQK + rc * 1024 + ch); const unsigned mk = in ? 0xffffffffu : 0u;
        xr[i] = (u32x4){w.x & mk, w.y & mk, w.z & mk, w.w & mk}; }
}
__device__ __forceinline__ void conv_compute(const u32x4 (&xr)[6], int ch, const float* __restrict__ cw, const float* __restrict__ cbias, float (&o0)[8], float (&o1)[8]) {
    asm volatile("" : "+v"(ch));
    const f32x4 b0 = *(const f32x4*)(cbias + ch), b1 = *(const f32x4*)(cbias + ch + 4);
#pragma unroll
    for (int e = 0; e < 8; ++e) { o0[e] = e < 4 ? b0[e & 3] : b1[e & 3]; o1[e] = o0[e]; }
#define XV(i, e) (((e) & 1) ? bfhi(xr[i][(e) >> 1]) : bflo(xr[i][(e) >> 1]))
#pragma unroll
    for (int j = 0; j < 5; ++j) { const f32x4 w0 = *(const f32x4*)(cw + j * 1024 + ch), w1 = *(const f32x4*)(cw + j * 1024 + ch + 4);
#pragma unroll
        for (int e = 0; e < 8; ++e) { const float w = e < 4 ? w0[e & 3] : w1[e & 3]; o0[e] += w * XV(j, e); o1[e] += w * XV(j + 1, e); } }
#undef XV
#pragma unroll
    for (int e = 0; e < 8; ++e) { o0[e] = o0[e] * sigmoidf_(o0[e]); o1[e] = o1[e] * sigmoidf_(o1[e]); }
}
__device__ __forceinline__ void vt_load(const bf16_t* __restrict__ HVO, long t0, int h, int tid, u32x4 (&w)[2]) {
    const int cc = (tid & 3) | (((tid >> 7) & 3) << 2), s = (tid >> 2) & 31;
#pragma unroll
    for (int half = 0; half < 2; ++half) w[half] = *(const u32x4*)(HVO + (t0 + s + 32 * half) * 1024 + h * 128 + 8 * cc);
}
__device__ __forceinline__ void vt_scatter(const u32x4 (&wv)[2], LAS bf16_t* VT, int tid) {
    const int cc = (tid & 3) | (((tid >> 7) & 3) << 2), s = (tid >> 2) & 31;
#pragma unroll
    for (int half = 0; half < 2; ++half) { const int ss = s + 32 * half; const u32x4 w = wv[half];
        LAS bf16_t* p = VT + (8 * cc) * 72 + ss;
        p[0 * 72] = (bf16_t)(w.x & 0xffffu); p[1 * 72] = (bf16_t)(w.x >> 16); p[2 * 72] = (bf16_t)(w.y & 0xffffu); p[3 * 72] = (bf16_t)(w.y >> 16);
        p[4 * 72] = (bf16_t)(w.z & 0xffffu); p[5 * 72] = (bf16_t)(w.z >> 16); p[6 * 72] = (bf16_t)(w.w & 0xffffu); p[7 * 72] = (bf16_t)(w.w >> 16); }
}
constexpr float KSCALE = 0.08838834764831845f;

constexpr int NCH = 32;
__device__ __forceinline__ f32x16 mfma32(bf16x8 a, bf16x8 b, f32x16 c) { return __builtin_amdgcn_mfma_f32_32x32x16_bf16(a, b, c, 0, 0, 0); }
__device__ __forceinline__ void mlstm_pass1_unit(const Ptrs& P, LAS unsigned char* lds, int b, int h, int c, int tid) {
    asm volatile("" : "+v"(tid));
    const int lane = tid & 63, wid = __builtin_amdgcn_readfirstlane(tid >> 6);
    LAS float* W = (LAS float*)lds;
    LAS float* SC = (LAS float*)(lds + 2048);
    LAS bf16_t* KTW = (LAS bf16_t*)(lds + 4096);
    LAS bf16_t* VT = (LAS bf16_t*)(lds + 4096 + 36864);
    const long t0 = (long)b * SEQ + 256 * c;
    { const int dir = tid >> 8, j = tid & 255, o = dir ? 255 - j : j; const long t = t0 + o; const int base = wid & 4, w4 = wid & 3;
      const float f = P.G32[t * 16 + dir * 8 + 4 + h] + P.fg_b[dir * 4 + h], ig = P.G32[t * 16 + dir * 8 + h] + P.ig_b[dir * 4 + h];
      const float incl = wave_scan_add(logsig_(f), lane); if (lane == 63) SC[wid] = incl;
      __syncthreads();
      const float off = (w4 > 0 ? SC[base] : 0.f) + (w4 > 1 ? SC[base + 1] : 0.f) + (w4 > 2 ? SC[base + 2] : 0.f);
      const float bl = (SC[base] + SC[base + 1]) + (SC[base + 2] + SC[base + 3]);
      const float we = bl - (incl + off) + ig, wm = wave_max(we); if (lane == 0) SC[8 + wid] = wm;
      __syncthreads();
      const float mloc = fmaxf(fmaxf(SC[8 + base], SC[8 + base + 1]), fmaxf(SC[8 + base + 2], SC[8 + base + 3]));
      W[dir * 256 + o] = __expf(we - mloc);
      if (j == 0) { const int chain = (dir * 2 + b) * 4 + h, cd = dir ? NCH - 1 - c : c; P.BL[chain * NCH + cd] = bl; P.ML[chain * NCH + cd] = mloc; }
    }
    __syncthreads();
    const int dirw = wid >> 2, mb = wid & 3, l15 = lane & 15, lq = lane >> 4;
    f32x4 acc[2][8];
#pragma unroll
    for (int mt = 0; mt < 2; ++mt)
#pragma unroll
        for (int nt = 0; nt < 8; ++nt) acc[mt][nt] = (f32x4){0.f, 0.f, 0.f, 0.f};
    float unacc = 0.f;
#pragma unroll 1
    for (int sub = 0; sub < 4; ++sub) {
        const long ts = t0 + 64 * sub;
        int tl = tid; asm volatile("" : "+v"(tl));
        const int ll15 = tl & 15, llq = (tl & 63) >> 4;
        { const int tg = (tl >> 2) & 31, cc = (tl & 3) | (((tl >> 7) & 3) << 2); float k0[8], k1[8];
          u32x4 xq[6], xk[6], wv[2];
          conv_load(P.HQK, ts, (long)b * SEQ, (long)(b + 1) * SEQ, h * 128 + 8 * cc, tg, xq);
          conv_compute(xq, h * 128 + 8 * cc, P.conv_w, P.conv_b, k0, k1);
          { u32x4 w0, w1; w0.x = pk2(k0[0], k0[1]); w0.y = pk2(k0[2], k0[3]); w0.z = pk2(k0[4], k0[5]); w0.w = pk2(k0[6], k0[7]);
            w1.x = pk2(k1[0], k1[1]); w1.y = pk2(k1[2], k1[3]); w1.z = pk2(k1[4], k1[5]); w1.w = pk2(k1[6], k1[7]);
            *(u32x4*)(P.QC + (ts + 2 * tg) * 512 + h * 128 + 8 * cc) = w0; *(u32x4*)(P.QC + (ts + 2 * tg + 1) * 512 + h * 128 + 8 * cc) = w1; }
          asm volatile("" ::: "memory");
          conv_load(P.HQK, ts, (long)b * SEQ, (long)(b + 1) * SEQ, 512 + h * 128 + 8 * cc, tg, xk);
          vt_load(P.HVO, ts, h, tl, wv);
          conv_compute(xk, 512 + h * 128 + 8 * cc, P.conv_w, P.conv_b, k0, k1);
#pragma unroll
          for (int e = 0; e < 8; ++e) { k0[e] *= KSCALE; k1[e] *= KSCALE; }
          { u32x4 w0, w1; w0.x = pk2(k0[0], k0[1]); w0.y = pk2(k0[2], k0[3]); w0.z = pk2(k0[4], k0[5]); w0.w = pk2(k0[6], k0[7]);
            w1.x = pk2(k1[0], k1[1]); w1.y = pk2(k1[2], k1[3]); w1.z = pk2(k1[4], k1[5]); w1.w = pk2(k1[6], k1[7]);
            *(u32x4*)(P.KC + (ts + 2 * tg) * 512 + h * 128 + 8 * cc) = w0; *(u32x4*)(P.KC + (ts + 2 * tg + 1) * 512 + h * 128 + 8 * cc) = w1; }
          const int ow = 64 * sub + 2 * tg;
          const float wf0 = W[ow], wf1 = W[ow + 1], wb0 = W[256 + ow], wb1 = W[256 + ow + 1];
#pragma unroll
          for (int e = 0; e < 8; ++e) { const int dk = 8 * cc + e;
              *(LAS unsigned*)(KTW + dk * 72 + 2 * tg) = pk2(wf0 * k0[e], wf1 * k1[e]);
              *(LAS unsigned*)(KTW + (128 + dk) * 72 + 2 * tg) = pk2(wb0 * k0[e], wb1 * k1[e]); }
          vt_scatter(wv, VT, tl); }
        __syncthreads();
        { bf16x8 X[2][2];
#pragma unroll
          for (int mt = 0; mt < 2; ++mt)
#pragma unroll
              for (int ks = 0; ks < 2; ++ks) X[mt][ks] = *(const LAS bf16x8*)(KTW + (dirw * 128 + mb * 32 + mt * 16 + ll15) * 72 + ks * 32 + llq * 8);
#pragma unroll
          for (int nt = 0; nt < 8; ++nt)
#pragma unroll
              for (int ks = 0; ks < 2; ++ks) { const bf16x8 Y = *(const LAS bf16x8*)(VT + (nt * 16 + ll15) * 72 + ks * 32 + llq * 8);
#pragma unroll
                  for (int mt = 0; mt < 2; ++mt) acc[mt][nt] = mfma16(X[mt][ks], Y, acc[mt][nt]); } }
        { const int d2 = tl >> 8, dk = (tl >> 1) & 127, hf = tl & 1;
#pragma unroll 8
          for (int i = 0; i < 32; ++i) unacc += bf2f(KTW[(d2 * 128 + dk) * 72 + hf * 32 + i]); }
#pragma unroll
        for (int i = 0; i < 2; ++i) { const int idx = tl + 512 * i, dv = idx >> 3, ch = idx & 7;
            *(u32x4*)(P.VTG + ((size_t)((b * 4 + h) * 128 + dv)) * SEQ + 256 * c + 64 * sub + 8 * ch) = *(const LAS u32x4*)(VT + dv * 72 + 8 * ch); }
        __syncthreads();
    }
    { const int chain = (dirw * 2 + b) * 4 + h, cd = dirw ? NCH - 1 - c : c;
      bf16_t* Ub = P.UC + (size_t)(chain * NCH + cd) * 16384;
#pragma unroll
      for (int mt = 0; mt < 2; ++mt)
#pragma unroll
          for (int nt = 0; nt < 8; ++nt) { const int dv = nt * 16 + l15, dk = mb * 32 + mt * 16 + 4 * lq; u32x2 w; w.x = pk2(acc[mt][nt][0], acc[mt][nt][1]); w.y = pk2(acc[mt][nt][2], acc[mt][nt][3]);
              *(u32x2*)(Ub + dv * 128 + dk) = w; } }
    { const int d2 = tid >> 8, dk = (tid >> 1) & 127, hf = tid & 1;
      unacc += __shfl_xor(unacc, 1);
      const int chain = (d2 * 2 + b) * 4 + h, cd = d2 ? NCH - 1 - c : c;
      if (hf == 0) P.UN[(size_t)(chain * NCH + cd) * 128 + dk] = unacc; }
    __syncthreads();
}
__device__ __forceinline__ void mlstm_pass2(const Ptrs& P, LAS unsigned char* lds, int vcu, int G, int tid) {
    LAS float* DEC = (LAS float*)lds; LAS float* BET = DEC + 512; LAS float* LBL = DEC + 1024; LAS float* LML = DEC + 1536;
    if (G == 256) {
        const int x = vcu >> 5, r = vcu & 31, bb = x >> 2, hh = x & 3;
        if (tid < 2 * NCH) { const int chain = ((tid >> 5) * 2 + bb) * 4 + hh; LBL[tid] = P.BL[chain * NCH + (tid & 31)]; LML[tid] = P.ML[chain * NCH + (tid & 31)]; }
        __syncthreads();
        if (tid < 2) { const int chain = (tid * 2 + bb) * 4 + hh; float m = 0.f;
            for (int c = 0; c < NCH; ++c) { const float bl = LBL[tid * NCH + c], ml = LML[tid * NCH + c]; if (r == 0) P.MP[chain * NCH + c] = m;
                const float mn = fmaxf(bl + m, ml); DEC[tid * NCH + c] = __expf(bl + m - mn); BET[tid * NCH + c] = __expf(ml - mn); m = mn; } }
        __syncthreads();
        { const int li = r * 512 + tid, dir = li >> 13, e2 = li & 8191, chain = (dir * 2 + bb) * 4 + hh;
          unsigned* p = (unsigned*)P.UC + (size_t)chain * NCH * 8192 + e2; float s0 = 0.f, s1 = 0.f;
          for (int c0 = 0; c0 < NCH; c0 += 8) { unsigned u[8];
#pragma unroll
              for (int k = 0; k < 8; ++k) u[k] = p[(size_t)(c0 + k) * 8192];
#pragma unroll
              for (int k = 0; k < 8; ++k) { const float d = DEC[dir * NCH + c0 + k], bt = BET[dir * NCH + c0 + k]; p[(size_t)(c0 + k) * 8192] = pk2(s0, s1);
                  s0 = d * s0 + bt * bflo(u[k]); s1 = d * s1 + bt * bfhi(u[k]); } } }
        if (r == 0 && tid < 256) { const int dir = tid >> 7, dk = tid & 127, chain = (dir * 2 + bb) * 4 + hh; float* p = P.UN + (size_t)chain * NCH * 128 + dk; float s = 0.f;
            for (int c = 0; c < NCH; ++c) { const float u = p[c * 128]; p[c * 128] = s; s = DEC[dir * NCH + c] * s + BET[dir * NCH + c] * u; } }
        __syncthreads();
        return;
    }
    if (tid < 16 * NCH) { LBL[tid] = P.BL[tid]; LML[tid] = P.ML[tid]; }
    __syncthreads();
    if (tid < 16) { const int chain = tid; float m = 0.f;
        for (int c = 0; c < NCH; ++c) { const float bl = LBL[chain * NCH + c], ml = LML[chain * NCH + c]; if (vcu == 0) P.MP[chain * NCH + c] = m;
            const float mn = fmaxf(bl + m, ml); DEC[chain * NCH + c] = __expf(bl + m - mn); BET[chain * NCH + c] = __expf(ml - mn); m = mn; } }
    __syncthreads();
    unsigned* UCw = (unsigned*)P.UC;
    for (int w = vcu * 512 + tid; w < 16 * 8192; w += G * 512) { const int chain = w >> 13, e2 = w & 8191; unsigned* p = UCw + (size_t)chain * NCH * 8192 + e2; float s0 = 0.f, s1 = 0.f;
        for (int c0 = 0; c0 < NCH; c0 += 8) { unsigned u[8];
#pragma unroll
            for (int k = 0; k < 8; ++k) u[k] = p[(size_t)(c0 + k) * 8192];
#pragma unroll
            for (int k = 0; k < 8; ++k) { const float d = DEC[chain * NCH + c0 + k], bt = BET[chain * NCH + c0 + k]; p[(size_t)(c0 + k) * 8192] = pk2(s0, s1);
                s0 = d * s0 + bt * bflo(u[k]); s1 = d * s1 + bt * bfhi(u[k]); } } }
    for (int w = vcu * 512 + tid; w < 2048; w += G * 512) { const int chain = w >> 7, dk = w & 127; float* p = P.UN + (size_t)chain * NCH * 128 + dk; float s = 0.f;
        for (int c = 0; c < NCH; ++c) { const float u = p[c * 128]; p[c * 128] = s; s = DEC[chain * NCH + c] * s + BET[chain * NCH + c] * u; } }
    __syncthreads();
}
__device__ __forceinline__ void mlstm_pass3_unit(const Ptrs& P, LAS unsigned char* lds, int b, int h, int c, int tid) {
    asm volatile("" : "+v"(tid));
    const int lane = tid & 63, wid = __builtin_amdgcn_readfirstlane(tid >> 6), l31 = lane & 31, hi = lane >> 5;
    LAS bf16_t* KS = (LAS bf16_t*)lds;
    LAS bf16_t* VT = (LAS bf16_t*)(lds + 69632);
    LAS float* PA = (LAS float*)(lds + 137216);
    LAS float* PMU = PA + 512; LAS float* PIW = PA + 1024; LAS float* PFL = PA + 1536; LAS float* SC = PA + 2048;
    const long t0 = (long)b * SEQ + 256 * c;
    u32x4 stg[16];
#pragma unroll
    for (int i = 0; i < 8; ++i) { const int idx = tid + 512 * i, row = idx >> 4, ch = idx & 15; stg[i] = *(const u32x4*)(P.KC + (t0 + row) * 512 + h * 128 + 8 * ch); }
#pragma unroll
    for (int i = 0; i < 8; ++i) { const int idx = tid + 512 * i, dv = idx >> 5, ch = idx & 31; stg[8 + i] = *(const u32x4*)(P.VTG + ((size_t)((b * 4 + h) * 128 + dv)) * SEQ + 256 * c + 8 * ch); }
    const int o1 = 32 * wid + l31;
    bf16x8 qf[8];
    { const bf16_t* qp = P.QC + (t0 + o1) * 512 + h * 128 + 8 * hi;
#pragma unroll
      for (int s = 0; s < 8; ++s) qf[s] = *(const bf16x8*)(qp + 16 * s); }
    { const int dir = tid >> 8, j = tid & 255, o = dir ? 255 - j : j; const long t = t0 + o; const int base = wid & 4, w4 = wid & 3;
      const int chain = (dir * 2 + b) * 4 + h, cd = dir ? NCH - 1 - c : c;
      const float f = P.G32[t * 16 + dir * 8 + 4 + h] + P.fg_b[dir * 4 + h], ig = P.G32[t * 16 + dir * 8 + h] + P.ig_b[dir * 4 + h];
      const float incl = wave_scan_add(logsig_(f), lane); if (lane == 63) SC[wid] = incl;
      __syncthreads();
      const float off = (w4 > 0 ? SC[base] : 0.f) + (w4 > 1 ? SC[base + 1] : 0.f) + (w4 > 2 ? SC[base + 2] : 0.f);
      const float bs = incl + off, a = ig - bs, imax = wave_scan_max(a, lane); if (lane == 63) SC[8 + wid] = imax;
      __syncthreads();
      float pm = -__builtin_inff(); if (w4 > 0) pm = SC[8 + base]; if (w4 > 1) pm = fmaxf(pm, SC[8 + base + 1]); if (w4 > 2) pm = fmaxf(pm, SC[8 + base + 2]);
      const float mp = P.MP[chain * NCH + cd], mu = fmaxf(mp, fmaxf(imax, pm));
      PA[dir * 256 + o] = a; PMU[dir * 256 + o] = mu; PIW[dir * 256 + o] = __expf(mp - mu); PFL[dir * 256 + o] = __expf(-(bs + mu)); }
#pragma unroll
    for (int i = 0; i < 8; ++i) { const int idx = tid + 512 * i, row = idx >> 4, ch = idx & 15; *(LAS u32x4*)(KS + row * 136 + 8 * ch) = stg[i]; }
#pragma unroll
    for (int i = 0; i < 8; ++i) { const int idx = tid + 512 * i, dv = idx >> 5, ch = idx & 31; *(LAS u32x4*)(VT + dv * 264 + 8 * ch) = stg[8 + i]; }
    __syncthreads();
    f32x16 hs[4];
#pragma unroll
    for (int dir = 0; dir < 2; ++dir) {
        const int chain = (dir * 2 + b) * 4 + h, cd = dir ? NCH - 1 - c : c;
        const float mu1 = PMU[dir * 256 + o1], iw1 = PIW[dir * 256 + o1], fl1 = PFL[dir * 256 + o1];
        f32x16 acc[4];
#define CLD4(dst, D, S0) do { int ll_ = lane; asm volatile("" : "+v"(ll_)); const bf16_t* cp_ = P.UC + (size_t)(chain * NCH + cd) * 16384 + (32 * (D) + (ll_ & 31)) * 128 + 8 * (ll_ >> 5) + 16 * (S0); \
            _Pragma("unroll") for (int s_ = 0; s_ < 4; ++s_) dst[s_] = *(const bf16x8*)(cp_ + 16 * s_); } while (0)
#define MM4(D, src, S0) do { _Pragma("unroll") for (int s_ = 0; s_ < 4; ++s_) acc[D] = mfma32(src[s_], qf[(S0) + s_], acc[D]); } while (0)
        if (dir == 0) {
            bf16x8 ca[4], cb[4], cc[4];
            CLD4(ca, 0, 0); CLD4(cb, 0, 4);
#pragma unroll
            for (int d = 0; d < 4; ++d) { acc[d] = f32x16{};
                if (d < 3) CLD4(cc, d + 1, 0);
                __builtin_amdgcn_sched_barrier(0); MM4(d, ca, 0); __builtin_amdgcn_sched_barrier(0);
                if (d < 3) CLD4(ca, d + 1, 4);
                __builtin_amdgcn_sched_barrier(0); MM4(d, cb, 4); acc[d] *= iw1; __builtin_amdgcn_sched_barrier(0);
                if (d < 3) {
#pragma unroll
                    for (int s_ = 0; s_ < 4; ++s_) { const bf16x8 t_ = ca[s_]; ca[s_] = cc[s_]; cb[s_] = t_; } } }
        } else {
#pragma unroll
            for (int d = 0; d < 4; ++d) { acc[d] = f32x16{}; bf16x8 ca[4], cb[4]; CLD4(ca, d, 0); CLD4(cb, d, 4);
                MM4(d, ca, 0); MM4(d, cb, 4); acc[d] *= iw1; asm volatile("" ::: "memory"); __builtin_amdgcn_sched_barrier(0); }
        }
#undef CLD4
#undef MM4
        float qn = 0.f;
        { const float* np = P.UN + (size_t)(chain * NCH + cd) * 128 + 8 * hi;
#pragma unroll
          for (int s = 0; s < 8; ++s) { const f32x4 n0 = *(const f32x4*)(np + 16 * s), n1 = *(const f32x4*)(np + 16 * s + 4); const u32x4 w = __builtin_bit_cast(u32x4, qf[s]);
              qn += bflo(w.x) * n0[0] + bfhi(w.x) * n0[1] + bflo(w.y) * n0[2] + bfhi(w.y) * n0[3] + bflo(w.z) * n1[0] + bfhi(w.z) * n1[1] + bflo(w.w) * n1[2] + bfhi(w.w) * n1[3]; }
          qn += __shfl_xor(qn, 32); }
        float dsum = 0.f;
        const int kb_lo = dir ? wid : 0, kb_hi = dir ? 7 : wid;
#pragma unroll 1
        for (int kb = kb_lo; kb <= kb_hi; ++kb) {
            int ll = lane; asm volatile("" : "+v"(ll));
            const int l31 = ll & 31, hi = ll >> 5;
            f32x16 S = f32x16{};
#pragma unroll
            for (int s = 0; s < 8; ++s) { const bf16x8 A = *(const LAS bf16x8*)(KS + (32 * kb + l31) * 136 + 16 * s + 8 * hi); S = mfma32(A, qf[s], S); if ((s & 3) == 3) __builtin_amdgcn_sched_barrier(0); }
            const bool diag = (kb == wid);
#pragma unroll
            for (int i = 0; i < 4; ++i) { const f32x4 a4 = *(const LAS f32x4*)(PA + dir * 256 + 32 * kb + 8 * i + 4 * hi);
#pragma unroll
                for (int e = 0; e < 4; ++e) { const int key = 32 * kb + 8 * i + 4 * hi + e; const bool ok = !diag || (dir ? (key >= o1) : (key <= o1));
                    const float p = ok ? S[4 * i + e] * __expf(fminf(a4[e] - mu1, 0.f)) : 0.f; dsum += p; S[4 * i + e] = p; } }
            u32x4 w0, w1; w0.x = pk2(S[0], S[1]); w0.y = pk2(S[2], S[3]); w0.z = pk2(S[4], S[5]); w0.w = pk2(S[6], S[7]);
            w1.x = pk2(S[8], S[9]); w1.y = pk2(S[10], S[11]); w1.z = pk2(S[12], S[13]); w1.w = pk2(S[14], S[15]);
            const bf16x8 pf0 = __builtin_bit_cast(bf16x8, w0), pf1 = __builtin_bit_cast(bf16x8, w1);
#pragma unroll
            for (int d = 0; d < 4; ++d) { const LAS bf16_t* vp = VT + (32 * d + l31) * 264 + 32 * kb + 4 * hi;
                u32x4 A0, A1; { const u32x2 lo = *(const LAS u32x2*)vp, hh = *(const LAS u32x2*)(vp + 8); A0 = (u32x4){lo.x, lo.y, hh.x, hh.y}; }
                { const u32x2 lo = *(const LAS u32x2*)(vp + 16), hh = *(const LAS u32x2*)(vp + 24); A1 = (u32x4){lo.x, lo.y, hh.x, hh.y}; }
                acc[d] = mfma32(__builtin_bit_cast(bf16x8, A0), pf0, acc[d]); acc[d] = mfma32(__builtin_bit_cast(bf16x8, A1), pf1, acc[d]); __builtin_amdgcn_sched_barrier(0); }
        }
        dsum += __shfl_xor(dsum, 32);
        const float den = iw1 * qn + dsum, dinv = 1.f / fmaxf(fabsf(den), fl1);
#pragma unroll
        for (int d = 0; d < 4; ++d) { if (dir == 0) hs[d] = acc[d] * dinv; else hs[d] += acc[d] * dinv; }
    }
    float ss = 0.f;
#pragma unroll
    for (int d = 0; d < 4; ++d)
#pragma unroll
        for (int r = 0; r < 16; ++r) ss += hs[d][r] * hs[d][r];
    ss += __shfl_xor(ss, 32);
    const float rn = rsqrtf(ss * (1.f / 128.f) + NORM_EPS);
#pragma unroll
    for (int dd = 0; dd < 2; ++dd) {
        int ll = lane; asm volatile("" : "+v"(ll)); const int hi = ll >> 5, o1 = 32 * wid + (ll & 31);
        u32x2 mo[8]; f32x4 g4[8];
        { const bf16_t* mp_ = P.HVO + (t0 + o1) * 1024 + 512 + h * 128 + 64 * dd + 4 * hi;
#pragma unroll
          for (int j = 0; j < 8; ++j) mo[j] = *(const u32x2*)(mp_ + 8 * j); }
#pragma unroll
        for (int j = 0; j < 8; ++j) g4[j] = *(const f32x4*)(P.g_on + h * 128 + 64 * dd + 8 * j + 4 * hi);
#pragma unroll
        for (int j = 0; j < 8; ++j) { const int d = 2 * dd + (j >> 2), i = j & 3; const u32x2 m = mo[j]; bf16_t* mp = P.YM + (t0 + o1) * 1024 + h * 128 + 64 * dd + 8 * j + 4 * hi;
            u32x2 w; w.x = pk2(hs[d][4 * i] * rn * g4[j][0] * sigmoidf_(bflo(m.x)), hs[d][4 * i + 1] * rn * g4[j][1] * sigmoidf_(bfhi(m.x)));
            w.y = pk2(hs[d][4 * i + 2] * rn * g4[j][2] * sigmoidf_(bflo(m.y)), hs[d][4 * i + 3] * rn * g4[j][3] * sigmoidf_(bfhi(m.y)));
            *(u32x2*)mp = w; }
        asm volatile("" ::: "memory"); __builtin_amdgcn_sched_barrier(0); }
    __syncthreads();
}

#define XB_TMO      128
#define XB_MISMATCH 192
#define XB_XCNT(j)  (256  + 64 * (j))
#define XB_XSUB(j)  (1280 + 64 * (j))
#define XB_XGEN(j)  (2304 + 64 * (j))
#define XB_TOP      3328
#define XB_TOPGEN   3392
#define XCD_BAR_WORDS 3456
#define XB_SPIN_CAP (1u << 18)
__device__ __forceinline__ unsigned xb_ld(unsigned* p)              { return __hip_atomic_load(p, __ATOMIC_RELAXED, __HIP_MEMORY_SCOPE_AGENT); }
__device__ __forceinline__ unsigned xb_add(unsigned* p, unsigned v) { return __hip_atomic_fetch_add(p, v, __ATOMIC_RELAXED, __HIP_MEMORY_SCOPE_AGENT); }
__device__ __forceinline__ unsigned xb_xcc_id() { return (unsigned)__builtin_amdgcn_s_getreg((3 << 11) | 20) & 0xFu; }
#define XB_SPIN(cond, bar) do { unsigned _sp = 0; while (cond) { __builtin_amdgcn_s_sleep(1); \
    if ((++_sp & 255u) == 0u) { if (xb_ld(&(bar)[XB_TMO])) break; if (_sp > XB_SPIN_CAP) { atomicAdd(&(bar)[XB_TMO], 1u); break; } } } } while (0)
struct XcdBarrier { unsigned* bar; unsigned x; volatile LAS unsigned* st; };
__device__ __forceinline__ XcdBarrier xcd_barrier_post(unsigned* bar, volatile LAS unsigned* st) {
    XcdBarrier b; b.bar = bar; b.x = xb_xcc_id(); b.st = st;
    if (threadIdx.x == 0) { if (b.x != (blockIdx.x & 7u)) (void)xb_add(&bar[XB_MISMATCH], 1u); (void)xb_add(&bar[XB_XCNT(b.x)], 1u); }
    return b;
}
__device__ __forceinline__ void xcd_barrier_complete(unsigned* bar, unsigned x, unsigned& nloc, unsigned& nx) {
    const unsigned G = gridDim.x * gridDim.y * gridDim.z;
    unsigned sum, cnt, mine, sp = 0u;
    for (;;) {
        sum = 0u; cnt = 0u; mine = 0u;
#pragma unroll
        for (unsigned j = 0; j < 16; ++j) { const unsigned c = xb_ld(&bar[XB_XCNT(j)]); sum += c; cnt += (c > 0u) ? 1u : 0u; mine = (j == x) ? c : mine; }
        if (sum == G) break;
        __builtin_amdgcn_s_sleep(1);
        if ((++sp & 255u) == 0u) { if (xb_ld(&bar[XB_TMO])) break; if (sp > XB_SPIN_CAP) { atomicAdd(&bar[XB_TMO], 1u); break; } }
    }
    nloc = mine > 0u ? mine : 1u; nx = cnt > 0u ? cnt : 1u;
}
__device__ __forceinline__ void xcd_barrier(const XcdBarrier& b) {
    asm volatile("s_waitcnt vmcnt(0)" ::: "memory");
    __syncthreads();
    if (threadIdx.x == 0) {
        unsigned* bar = b.bar;
        __builtin_amdgcn_s_waitcnt(0);
        unsigned nloc = b.st[0], nx = b.st[1];
        if (nloc == 0u) { xcd_barrier_complete(bar, b.x, nloc, nx); b.st[0] = nloc; b.st[1] = nx; }
        const unsigned old = xb_add(&bar[XB_XSUB(b.x)], 1u);
        const unsigned gen = old / nloc;
        if (old + 1u == (gen + 1u) * nloc) {
            __builtin_amdgcn_fence(__ATOMIC_RELEASE, "agent");
            asm volatile("s_waitcnt vmcnt(0)" ::: "memory");
            const unsigned og = xb_add(&bar[XB_TOP], 1u);
            const unsigned tg = og / nx;
            if (og + 1u == (tg + 1u) * nx) xb_add(&bar[XB_TOPGEN], 1u);
            else XB_SPIN(xb_ld(&bar[XB_TOPGEN]) == tg, bar);
            __builtin_amdgcn_fence(__ATOMIC_ACQUIRE, "agent");
            xb_add(&bar[XB_XGEN(b.x)], 1u);
            asm volatile("s_waitcnt vmcnt(0)" ::: "memory");
        } else {
            XB_SPIN(xb_ld(&bar[XB_XGEN(b.x)]) == gen, bar);
            __builtin_amdgcn_fence(__ATOMIC_ACQUIRE, "agent");
            asm volatile("s_waitcnt vmcnt(0)" ::: "memory");
        }
    }
    __syncthreads();
}

__device__ __forceinline__ void xcd_local_barrier(const XcdBarrier& b, bool acq = true) {
    asm volatile("s_waitcnt vmcnt(0)" ::: "memory");
    __syncthreads();
    if (threadIdx.x == 0) {
        unsigned* bar = b.bar;
        __builtin_amdgcn_s_waitcnt(0);
        const unsigned nloc = b.st[0];
        const unsigned old = xb_add(&bar[XB_XSUB(b.x)], 1u);
        const unsigned gen = old / nloc;
        if (old + 1u == (gen + 1u) * nloc) { xb_add(&bar[XB_XGEN(b.x)], 1u); }
        else { XB_SPIN(xb_ld(&bar[XB_XGEN(b.x)]) == gen, bar); }
        if (acq) { __builtin_amdgcn_fence(__ATOMIC_ACQUIRE, "agent"); asm volatile("s_waitcnt vmcnt(0)" ::: "memory"); }
    }
    __syncthreads();
}

__device__ __forceinline__ void xcd_local_barrier_post(const XcdBarrier& b, unsigned* gcnt) {
    asm volatile("s_waitcnt vmcnt(0)" ::: "memory");
    __syncthreads();
    if (threadIdx.x == 0) {
        unsigned* bar = b.bar;
        __builtin_amdgcn_s_waitcnt(0);
        const unsigned nloc = b.st[0];
        const unsigned old = xb_add(&bar[XB_XSUB(b.x)], 1u);
        const unsigned gen = old / nloc;
        if (old + 1u == (gen + 1u) * nloc) {
            xb_add(&bar[XB_XGEN(b.x)], 1u);
            __builtin_amdgcn_fence(__ATOMIC_RELEASE, "agent"); asm volatile("s_waitcnt vmcnt(0)" ::: "memory");
            (void)xb_add(gcnt, 1u);
        } else { XB_SPIN(xb_ld(&bar[XB_XGEN(b.x)]) == gen, bar); }
        __builtin_amdgcn_fence(__ATOMIC_ACQUIRE, "agent");
        asm volatile("s_waitcnt vmcnt(0)" ::: "memory");
    }
    __syncthreads();
}
__device__ __forceinline__ void count_wait(unsigned* cnt, unsigned target) {
    if (threadIdx.x == 0) { unsigned sp_ = 0; while (xb_ld(cnt) < target) { __builtin_amdgcn_s_sleep(2); if (++sp_ > (1u << 22)) break; }
        __builtin_amdgcn_fence(__ATOMIC_ACQUIRE, "agent"); asm volatile("s_waitcnt vmcnt(0)" ::: "memory"); }
    __syncthreads();
}

__device__ __forceinline__ float wave_sum(float v) {
#pragma unroll
    for (int o = 1; o < 64; o <<= 1) v += __shfl_xor(v, o);
    return v;
}
__device__ __forceinline__ int map_row(int mode, int n) {
    if (mode == 1) { if (n < 672) return n; if (n < 2720) return n + 96; if (n < 2736) return n - 2048; return n + 80; }
    if (mode == 2) { const int hh = n / 96, d = n % 96; if (d < 64) return n; const int r = d - 64;
        const int p = (r < 16) ? 8 * (r >> 2) + (r & 3) : 8 * ((r - 16) >> 2) + 4 + ((r - 16) & 3); return hh * 96 + 64 + p; }
    return n;
}
__device__ __forceinline__ void p0_transpose_item(const float* __restrict__ W, int K, int N, bf16_t* WT, int ldw, int mode, const float* __restrict__ gain, int item, int lane) {
    const int nblk = (N + 63) / 64, kb = item / nblk, nb = item % nblk, k0 = 32 * kb, n = 64 * nb + lane;
    if (n < N) {
        float v[32];
#pragma unroll
        for (int i = 0; i < 32; ++i) v[i] = __builtin_nontemporal_load(&W[(size_t)(k0 + i) * N + n]);
        if (gain) {
#pragma unroll
            for (int i = 0; i < 32; ++i) v[i] *= gain[k0 + i]; }
        bf16_t* dst = WT + (size_t)map_row(mode, n) * ldw + k0;
#pragma unroll
        for (int j = 0; j < 4; ++j) { u32x4 o; o.x = pk2(v[8 * j], v[8 * j + 1]); o.y = pk2(v[8 * j + 2], v[8 * j + 3]); o.z = pk2(v[8 * j + 4], v[8 * j + 5]); o.w = pk2(v[8 * j + 6], v[8 * j + 7]);
            *(u32x4*)(dst + 8 * j) = o; }
    }
}
__device__ __forceinline__ void sincos_acc(float ang, float& sn, float& cs) {
    const double x = (double)ang; const double kq = __builtin_rint(x * 0.63661977236758134308); const double r = x - kq * 1.57079632679489661923; const double r2 = r * r;
    const double s = r * (1.0 + r2 * (-1.0 / 6 + r2 * (1.0 / 120 + r2 * (-1.0 / 5040 + r2 * (1.0 / 362880 + r2 * (-1.0 / 39916800 + r2 * (1.0 / 6227020800.0)))))));
    const double c = 1.0 + r2 * (-0.5 + r2 * (1.0 / 24 + r2 * (-1.0 / 720 + r2 * (1.0 / 40320 + r2 * (-1.0 / 3628800 + r2 * (1.0 / 479001600.0 + r2 * (-1.0 / 87178291200.0)))))));
    const int q = ((int)kq) & 3;
    const double ss = (q == 0) ? s : (q == 1) ? c : (q == 2) ? -s : -c, cc = (q == 0) ? c : (q == 1) ? -s : (q == 2) ? -c : s;
    sn = (float)ss; cs = (float)cc;
}

constexpr int LDS_BYTES = 149504;
constexpr int MISC_OFF = LDS_BYTES - 128;
struct Args { const void* in[20]; float* out; unsigned char* ws; int ph_lo, ph_hi, li, pad; };

#define MKP() \
    Ptrs P; \
    P.x = (const float*)args.in[0]; P.pos = (const int*)args.in[1]; P.g_mix = (const float*)args.in[2]; P.w_in = (const float*)args.in[3]; P.g_q = (const float*)args.in[4]; \
    P.w_uq = (const float*)args.in[5]; P.g_kv = (const float*)args.in[6]; P.w_ukv = (const float*)args.in[7]; P.conv_w = (const float*)args.in[8]; P.conv_b = (const float*)args.in[9]; \
    P.ig_b = (const float*)args.in[10]; P.fg_b = (const float*)args.in[11]; P.g_on = (const float*)args.in[12]; P.w_bm = (const float*)args.in[13]; P.w_bl = (const float*)args.in[14]; \
    P.w_out = (const float*)args.in[15]; P.g_mlp = (const float*)args.in[16]; P.w_up = (const float*)args.in[17]; P.w_dn = (const float*)args.in[18]; P.g_fin = (const float*)args.in[19]; \
    P.out = args.out; P.ws = args.ws; \
    P.WinT = (bf16_t*)(ws + WS_WIN); P.WuqT = (bf16_t*)(ws + WS_WUQ); P.WukvT = (bf16_t*)(ws + WS_WUKV); P.WbmT = (bf16_t*)(ws + WS_WBM); P.WblT = (bf16_t*)(ws + WS_WBL); \
    P.WoutT = (bf16_t*)(ws + WS_WOUT); P.WupT = (bf16_t*)(ws + WS_WUP); P.WdnT = (bf16_t*)(ws + WS_WDN); \
    P.ROPE = (float*)(ws + WS_ROPE); P.SSQ = (float*)(ws + WS_SSQ); P.SSQ1 = (float*)(ws + WS_SSQ1); P.SSQ2 = (float*)(ws + WS_SSQ2); P.G32 = (float*)(ws + WS_G32); \
    P.UN = (float*)(ws + WS_UN); P.BL = (float*)(ws + WS_BL); P.ML = (float*)(ws + WS_ML); P.MP = (float*)(ws + WS_MP); \
    P.H0 = (bf16_t*)(ws + WS_H0); P.HQK = (bf16_t*)(ws + WS_HQK); P.HVO = (bf16_t*)(ws + WS_HVO); P.HG = (bf16_t*)(ws + WS_HG); \
    P.XN = (bf16_t*)(ws + WS_XN); P.UC = (bf16_t*)(ws + WS_UC); P.QC = (bf16_t*)(ws + WS_QC); P.KC = (bf16_t*)(ws + WS_KC); P.VTG = (bf16_t*)(ws + WS_VTG); P.G1 = (bf16_t*)(ws + WS_G1); P.MERGED = (bf16_t*)(ws + WS_MERGED); P.X1B = (bf16_t*)(ws + WS_X1B); \
    P.ACT = (bf16_t*)(ws + WS_ACT); P.YA = (bf16_t*)(ws + WS_YA); P.YM = (bf16_t*)(ws + WS_YM); \
    P.Q = (bf16_t*)((unsigned char*)args.out + DO_Q); P.KV = (bf16_t*)((unsigned char*)args.out + DO_KV); P.KR = (bf16_t*)((unsigned char*)args.out + DO_KR);

__global__ void __launch_bounds__(NWAVES * 64, 2) mk_fwd(Args args) {
    extern __shared__ __attribute__((aligned(16))) unsigned char lds_raw[];
    LAS unsigned char* lds = (LAS unsigned char*)lds_raw;
    const int tid = threadIdx.x, lane = tid & 63, wave = __builtin_amdgcn_readfirstlane(tid >> 6);
    const int G = gridDim.x; const int bx = blockIdx.x; const int vcu = (G % 8 == 0) ? (bx % 8) * (G / 8) + bx / 8 : bx;
    unsigned char* ws = args.ws;
    volatile LAS unsigned* MISC = (volatile LAS unsigned*)(lds + MISC_OFF);
    { int t0_ = tid; asm volatile("" : "+v"(t0_)); for (int u = t0_; u < (LDS_BYTES - 131072) / 4; u += NWAVES * 64) ((LAS unsigned*)(lds + 131072))[u] = 0u; }
    __syncthreads();
#if !MK_SPLIT
    XcdBarrier bar = xcd_barrier_post((unsigned*)(ws + WS_CTL) + CW_BAR, MISC + 8);
#define SEAM(k) do { if (IN((k) + 1)) xcd_barrier(bar); } while (0)
#define SEAML(k) do { if (IN((k) + 1)) { if (MISC[12]) xcd_local_barrier(bar, (k) == 7); else xcd_barrier(bar); } } while (0)
#else
#define SEAM(k) do { } while (0)
#define SEAML(k) do { } while (0)
#endif
    const int lo = args.ph_lo, hi = args.ph_hi;
#ifndef PH_MASK
#define PH_MASK 0x3ff
#endif
#define IN(k) (((PH_MASK >> (k)) & 1) && lo <= (k) && (k) < hi)
    const int gw = vcu * NWAVES + wave, NGW = G * NWAVES;

    if (IN(0)) { MKP();
#pragma unroll 1
      for (int rep = 0; rep < ((PROBE_DUP & 16) ? 2 : 1); ++rep) {
        constexpr int I_IN = (1024 / 32) * ((IN_COLS + 63) / 64), I_UQ = (384 / 32) * (768 / 64), I_UKV = (256 / 32) * (1024 / 64), I_BM = (512 / 32) * (1024 / 64), I_BL = I_BM,
                      I_OUT = (1024 / 32) * (1024 / 64), I_UP = (1024 / 32) * (4096 / 64), I_DN = (4096 / 32) * (1024 / 64);
        constexpr int NITEMS = I_IN + I_UQ + I_UKV + I_BM + I_BL + I_OUT + I_UP + I_DN;
        constexpr int NEARLY = I_IN + I_UQ + I_UKV;
#pragma unroll 1
      for (int stage = 0; stage < 2; ++stage) {
#pragma unroll 1
            for (int it = (stage ? NEARLY : 0) + gw; it < (stage ? NITEMS : NEARLY); it += NGW) {
                int r = it; const float* W; const float* gn = nullptr; bf16_t* WT; int K_, N_, mode = 0, ldw = 0;
                if (r < I_IN) { W = P.w_in; K_ = 1024; N_ = IN_COLS; WT = P.WinT; mode = 1; }
                else if ((r -= I_IN) < I_UQ) { W = P.w_uq; K_ = 384; N_ = 768; WT = P.WuqT; mode = 2; gn = P.g_q; }
                else if ((r -= I_UQ) < I_UKV) { W = P.w_ukv; K_ = 256; N_ = 1024; WT = P.WukvT; gn = P.g_kv; }
                else if ((r -= I_UKV) < I_BM) { W = P.w_bm; K_ = 512; N_ = 1024; WT = P.WbmT; ldw = 1024; }
                else if ((r -= I_BM) < I_BL) { W = P.w_bl; K_ = 512; N_ = 1024; WT = P.WbmT + 512; ldw = 1024; }
                else if ((r -= I_BL) < I_OUT) { W = P.w_out; K_ = 1024; N_ = 1024; WT = P.WoutT; }
                else if ((r -= I_OUT) < I_UP) { W = P.w_up; K_ = 1024; N_ = 4096; WT = P.WupT; gn = P.g_mlp; }
                else { r -= I_UP; W = P.w_dn; K_ = 4096; N_ = 1024; WT = P.WdnT; }
                p0_transpose_item(W, K_, N_, WT, ldw ? ldw : K_, mode, gn, r, lane);
            }
        if (stage == 0) {
        for (int i = vcu * 512 + tid; i < 80 * 1024 / 8; i += G * 512) *(u32x4*)(P.WinT + (size_t)688 * 1024 + (size_t)i * 8) = (u32x4){0u, 0u, 0u, 0u};
#pragma unroll 1
        for (int m = gw; m < M; m += 2 * NGW) {
            const int m2 = m + NGW;
            const f32x4* xa = (const f32x4*)(P.x + (size_t)m * 1024) + lane; const f32x4* xb = (const f32x4*)(P.x + (size_t)(m2 < M ? m2 : m) * 1024) + lane;
            f32x4 va[4], vb[4]; float sa = 0.f, sb = 0.f;
#pragma unroll
            for (int j = 0; j < 4; ++j) { va[j] = __builtin_nontemporal_load(&xa[64 * j]); vb[j] = __builtin_nontemporal_load(&xb[64 * j]); }
#pragma unroll
            for (int j = 0; j < 4; ++j) { sa += dot4(va[j]); sb += dot4(vb[j]); }
            const float ra = rsqrtf(wave_sum(sa) * (1.f / 1024.f) + NORM_EPS), rb = rsqrtf(wave_sum(sb) * (1.f / 1024.f) + NORM_EPS);
            u32x2* oa = (u32x2*)(P.XN + (size_t)m * 1024) + lane; u32x2* ob = (u32x2*)(P.XN + (size_t)m2 * 1024) + lane;
#pragma unroll
            for (int j = 0; j < 4; ++j) { const f32x4 g4 = *((const f32x4*)P.g_mix + lane + 64 * j); u32x2 w;
                w.x = pk2(va[j][0] * ra * g4[0], va[j][1] * ra * g4[1]); w.y = pk2(va[j][2] * ra * g4[2], va[j][3] * ra * g4[3]); st8wt(oa + 64 * j, w);
                if (m2 < M) { w.x = pk2(vb[j][0] * rb * g4[0], vb[j][1] * rb * g4[1]); w.y = pk2(vb[j][2] * rb * g4[2], vb[j][3] * rb * g4[3]); st8wt(ob + 64 * j, w); } }
        }
#if !MK_SPLIT
          if (tid == 0) { unsigned nloc_ = MISC[8], nx_ = MISC[9]; if (nloc_ == 0u) { xcd_barrier_complete((unsigned*)(ws + WS_CTL) + CW_BAR, bar.x, nloc_, nx_); MISC[8] = nloc_; MISC[9] = nx_; }
              MISC[12] = (G == 256 && xb_ld((unsigned*)(ws + WS_CTL) + CW_BAR + XB_MISMATCH) == 0u) ? 1u : 0u; }
          __syncthreads();
          if (MISC[12]) xcd_local_barrier_post(bar, (unsigned*)(ws + WS_CTL) + CW_G0);
#endif
        } else {
        const bool xl_ = !MK_SPLIT && MISC[12];
        for (int i = xl_ ? (vcu >> 5) * 32768 + (vcu & 31) * 512 + tid : vcu * 512 + tid; i < (xl_ ? ((vcu >> 5) + 1) * 32768 : M * 16); i += xl_ ? 16384 : G * 512) { const int m = i >> 4, j = i & 15;
            const float invf = (float)exp(-(double)j * (9.210340371976184 / 16.0));
            const float ang = (float)P.pos[m] * invf; float sn, cs; sincos_acc(ang, sn, cs);
            P.ROPE[(size_t)m * 32 + j] = cs; P.ROPE[(size_t)m * 32 + 16 + j] = sn; }
        }
      }
      }
#if !MK_SPLIT
        if (MISC[12]) { if (IN(1)) count_wait((unsigned*)(ws + WS_CTL) + CW_G0, MISC[9]); }
        else
#endif
        SEAM(0);
    }
    if (IN(1)) { MKP();
        pg8::Gemm g{P.XN, P.WinT, M, NIN, 1024, 1024, 1024}; pg8::StaticOrder S; S.init(M, NIN, G, bx);
        EpiIn E{P.H0, P.HQK, P.HVO, P.HG, P.SSQ, P.G32};
#pragma unroll 1
        for (int rep = 0; rep < ((PROBE_DUP & 4) ? 2 : 1); ++rep)
        pg8::gemm_phase<EpiIn, pg8::StaticOrder>(lds, g, S, E);
#if !MK_SPLIT
        if (MISC[12]) { if (IN(2)) xcd_local_barrier_post(bar, (unsigned*)(ws + WS_CTL) + CW_G1); }
        else
#endif
        SEAM(1);
    }
    if (IN(2)) { MKP();
#ifndef P2M
#define P2M 15
#endif
      {
        if (PROBE_DUP & 32) { { pg8::Gemm g{P.H0, P.WuqT, M, 768, 384, 768, 384}; pg8::StaticOrder S; S.init(M, 768, G, bx); EpiQ E{P.Q, P.SSQ, P.ROPE}; pg8::gemm_phase<EpiQ, pg8::StaticOrder>(lds, g, S, E); }
          { pg8::Gemm g{P.H0 + 384, P.WukvT, M, 1024, 256, 768, 256}; pg8::StaticOrder S; S.init(M, 1024, G, bx); EpiKV E{P.KV, P.SSQ}; pg8::gemm_phase<EpiKV, pg8::StaticOrder>(lds, g, S, E); } }
        if (P2M & 1) { pg8::Gemm g{P.H0, P.WuqT, M, 768, 384, 768, 384}; pg8::StaticOrder S; S.init(M, 768, G, bx); EpiQ E{P.Q, P.SSQ, P.ROPE};
          pg8::gemm_phase<EpiQ, pg8::StaticOrder>(lds, g, S, E); }
        if (P2M & 2) { pg8::Gemm g{P.H0 + 384, P.WukvT, M, 1024, 256, 768, 256}; pg8::StaticOrder S; S.init(M, 1024, G, bx); EpiKV E{P.KV, P.SSQ};
          pg8::gemm_phase<EpiKV, pg8::StaticOrder>(lds, g, S, E); }
        const bool xloc = !MK_SPLIT && MISC[12];
        const int kr0 = xloc ? ((vcu >> 5) * 8192 + (vcu & 31) * 512 + tid) : vcu * 512 + tid, kr1 = xloc ? (((vcu & 31) < 16) ? ((vcu >> 5) + 1) * 8192 : 0) : M * 4, krs = xloc ? 16384 : G * 512;
        if (P2M & 4) for (int i = kr0; i < kr1; i += krs) { const int m = i >> 2, gq = i & 3;
            const u32x2 a = *(const u32x2*)(P.H0 + (size_t)m * 768 + 640 + 4 * gq), bb = *(const u32x2*)(P.H0 + (size_t)m * 768 + 656 + 4 * gq);
            const f32x4 x1 = (f32x4){bflo(a.x), bfhi(a.x), bflo(a.y), bfhi(a.y)}, x2 = (f32x4){bflo(bb.x), bfhi(bb.x), bflo(bb.y), bfhi(bb.y)};
            const f32x4 c = *(const f32x4*)(P.ROPE + (size_t)m * 32 + 4 * gq), s = *(const f32x4*)(P.ROPE + (size_t)m * 32 + 16 + 4 * gq);
            *(u32x4*)(P.KR + (size_t)m * 32 + 8 * gq) = pack8(x1 * c - x2 * s, x2 * c + x1 * s); }
        __syncthreads();
      }
#if !MK_SPLIT
        if (MISC[12]) count_wait((unsigned*)(ws + WS_CTL) + CW_G1, MISC[9]);
#endif
#pragma unroll 1
        for (int rep = 0; rep < ((PROBE_DUP & 2) ? 2 : 1); ++rep)
        if (P2M & 8) for (int unit = vcu; unit < 256; unit += G) mlstm_pass1_unit(P, lds, unit >> 7, (unit >> 5) & 3, unit & 31, tid);
#if !MK_SPLIT
        if (MISC[12]) { if (IN(3)) xcd_local_barrier_post(bar, (unsigned*)(ws + WS_CTL) + CW_G2); }
        else
#endif
        SEAM(2);
    }
    if (IN(3)) { MKP(); mlstm_pass2(P, lds, vcu, G, tid);
#if !MK_SPLIT
        if (MISC[12]) {
            asm volatile("s_waitcnt vmcnt(0)" ::: "memory"); __syncthreads();
            if (tid == 0) (void)xb_add((unsigned*)(ws + WS_CTL) + CW_S3 + 64 * (bx & 7), 1u);
            count_wait((unsigned*)(ws + WS_CTL) + CW_G2, MISC[9]);
        } else
#endif
        SEAM(3); }
    if (IN(4)) { MKP();
#pragma unroll 1
        for (int rep = 0; rep < ((PROBE_DUP & 1) ? 2 : 1); ++rep)
#pragma unroll 1
        for (int i = 0; i < 2 * ((512 + 2 * G - 1) / (2 * G)); ++i) { const int un = (i >> 1) * 2 * G + vcu * 2 + (i & 1); if (un >= 512) break;
            const int bh = un >> 5, qb = un & 31, b = bh >> 3, h = bh & 7; const long rowb = (long)b * SEQ;
            att::attn_unit(P.Q + (rowb + qb * 256) * 768 + h * 96, P.KV + rowb * 1024 + h * 128, P.KR + rowb * 32, P.YA + (rowb + qb * 256) * 1024 + h * 64, lds); }
        __syncthreads();
#if !MK_SPLIT
        if (MISC[12]) count_wait((unsigned*)(ws + WS_CTL) + CW_S3 + 64 * (bx & 7), MISC[8]);
#endif
#pragma unroll 1
        for (int rep = 0; rep < ((PROBE_DUP & 512) ? 2 : 1); ++rep)
        for (int unit = vcu; unit < 256; unit += G) mlstm_pass3_unit(P, lds, unit >> 7, (unit >> 5) & 3, unit & 31, tid);
        SEAM(4);
    }
    if (IN(5)) { MKP();
      {
        { pg8::Gemm g{P.YA, P.WbmT, M, 1024, 1024, 1024, 1024}; pg8::StaticOrder S; S.init(M, 1024, G, bx); EpiMergeF E{P.MERGED, P.HG};
          pg8::gemm_phase<EpiMergeF, pg8::StaticOrder>(lds, g, S, E); }
      }
#if !MK_SPLIT
        if (IN(6) && MISC[12]) { asm volatile("s_waitcnt vmcnt(0)" ::: "memory"); __syncthreads(); if (tid == 0) (void)xb_add((unsigned*)(ws + WS_CTL) + CW_P5, 1u); }
#endif
        SEAML(5);
    }
    if (IN(6)) { MKP();
        pg8::Gemm g{P.MERGED, P.WoutT, M, 1024, 1024, 1024, 1024}; pg8::StaticOrder S; S.init(M, 1024, G, bx); EpiRes E{P.x, (G == 256) ? nullptr : P.out, P.X1B, P.SSQ1, true};
#pragma unroll 1
        for (int rep = 0; rep < ((PROBE_DUP & 128) ? 2 : 1); ++rep)
        pg8::gemm_phase<EpiRes, pg8::StaticOrder>(lds, g, S, E);
        SEAML(6);
#if !MK_SPLIT
        if (IN(7) && MISC[12]) { if (tid == 0) { unsigned* c5_ = (unsigned*)(ws + WS_CTL) + CW_P5; unsigned sp_ = 0;
              while (xb_ld(c5_) < (unsigned)G) { __builtin_amdgcn_s_sleep(2); if (++sp_ > (1u << 22)) break; }
              __builtin_amdgcn_fence(__ATOMIC_ACQUIRE, "agent"); asm volatile("s_waitcnt vmcnt(0)" ::: "memory"); }
          __syncthreads(); }
#endif
    }
    if (IN(7)) { MKP();
        pg8::Gemm g{P.X1B, P.WupT, M, DFF, 1024, 1024, 1024}; pg8::StaticOrder S; S.init(M, DFF, G, bx); EpiUp E{P.ACT, P.SSQ1};
#pragma unroll 1
        for (int rep = 0; rep < ((PROBE_DUP & 8) ? 2 : 1); ++rep)
        pg8::gemm_phase<EpiUp, pg8::StaticOrder>(lds, g, S, E);
        SEAML(7);
    }
    if (IN(8)) { MKP();
        pg8::Gemm g{P.ACT, P.WdnT, M, 1024, DFF, DFF, DFF}; pg8::StaticOrder S; S.init(M, 1024, G, bx);
        if (G == 256) {
            EpiFinal E{P.X1B, P.out, P.g_fin, P.SSQ2, (unsigned*)(ws + WS_CTL) + CW_CNT};
            pg8::gemm_phase<EpiFinal, pg8::StaticOrder>(lds, g, S, E);
        } else {
            EpiRes E{P.out, P.out, nullptr, P.SSQ2, false};
            pg8::gemm_phase<EpiRes, pg8::StaticOrder>(lds, g, S, E);
            SEAM(8);
        }
    }
    if (IN(9) && G != 256) { MKP(); int t9_ = tid; asm volatile("" : "+v"(t9_)); const int lane = t9_ & 63;
        for (int m = gw; m < M; m += NGW) { float ss = 0.f;
#pragma unroll
            for (int p = 0; p < 16; ++p) ss += P.SSQ2[(size_t)p * M + m];
            const float rstd = rsqrtf(ss * (1.f / 1024.f) + NORM_EPS);
            f32x4* xr = (f32x4*)(P.out + (size_t)m * 1024) + lane;
#pragma unroll
            for (int j = 0; j < 4; ++j) { const f32x4 g4 = *((const f32x4*)P.g_fin + lane + 64 * j); xr[64 * j] = xr[64 * j] * rstd * g4; } }
    }
#undef IN
#undef SEAM
}

extern "C" void kernel_launch(void* const* d_in, const int* in_sizes, int n_in, void* d_out, int out_size, void* d_ws, size_t ws_size, hipStream_t stream) {
    static int grid = 0;
    if (grid == 0) {
        if (n_in != 20 || in_sizes[0] != M * DMODEL || out_size != M * DMODEL || ws_size < WS_END) { fprintf(stderr, "kernel_launch: shape mismatch (n_in %d in0 %d out %d ws %zu)\n", n_in, n_in > 0 ? in_sizes[0] : -1, out_size, ws_size); grid = -1; return; }
        int dev = 0, cus = 0;
        if (hipGetDevice(&dev) != hipSuccess || hipDeviceGetAttribute(&cus, hipDeviceAttributeMultiprocessorCount, dev) != hipSuccess) { grid = -1; return; }
        if (hipFuncSetAttribute((const void*)mk_fwd, hipFuncAttributeMaxDynamicSharedMemorySize, LDS_BYTES) != hipSuccess) { fprintf(stderr, "kernel_launch: hipFuncSetAttribute failed\n"); grid = -1; return; }
        int per_cu = 0;
        if (hipOccupancyMaxActiveBlocksPerMultiprocessor(&per_cu, (const void*)mk_fwd, NWAVES * 64, LDS_BYTES) != hipSuccess || per_cu < 1) fprintf(stderr, "kernel_launch: occupancy query reports %d\n", per_cu);
        (void)hipGetLastError();
        grid = cus;
    }
    if (grid < 0) return;
    if (hipMemsetAsync((char*)d_ws + WS_CTL, 0, CTL_ZERO_BYTES, stream) != hipSuccess) { fprintf(stderr, "kernel_launch: memset failed\n"); return; }
    Args a{};
    for (int i = 0; i < 20; ++i) a.in[i] = d_in[i];
    a.out = (float*)d_out; a.ws = (unsigned char*)d_ws;
#if MK_SPLIT
    for (int li = 0; li < NPHASE; ++li) { a.ph_lo = li; a.ph_hi = li + 1; a.li = li;
        hipLaunchKernelGGL(mk_fwd, dim3(grid), dim3(NWAVES * 64), LDS_BYTES, stream, a); }
#else
    a.ph_lo = 0; a.ph_hi = NPHASE; a.li = 0;
    hipLaunchKernelGGL(mk_fwd, dim3(grid), dim3(NWAVES * 64), LDS_BYTES, stream, a);
#endif
    const hipError_t le = hipPeekAtLastError();
    if (le != hipSuccess) fprintf(stderr, "kernel_launch: launch failed: %s\n", hipGetErrorName(le));
}
```

```cpp
#include <hip/hip_runtime.h>
#include <hip/hip_bf16.h>
#include <cstdio>
#include <cstdint>

#ifndef PROBE_DUP
#define PROBE_DUP 0
#endif
#ifndef MK_SPLIT
#define MK_SPLIT 0
#endif

#define LAS __attribute__((address_space(3)))
#define GAS __attribute__((address_space(1)))
typedef unsigned short bf16_t;
typedef short bf16x8 __attribute__((ext_vector_type(8)));
typedef short s16x4 __attribute__((ext_vector_type(4)));
typedef float f32x4 __attribute__((ext_vector_type(4)));
typedef float f32x16 __attribute__((ext_vector_type(16)));
typedef unsigned u32x4 __attribute__((ext_vector_type(4)));
typedef unsigned u32x2 __attribute__((ext_vector_type(2)));
typedef float f32x2_t __attribute__((ext_vector_type(2)));
typedef __bf16 bf16x2_t __attribute__((ext_vector_type(2)));

constexpr int BATCH = 2, SEQ = 8192, DMODEL = 1024, M = BATCH * SEQ;
constexpr int IN_COLS = 4784, NIN = 4864;
constexpr int DFF = 4096;
constexpr float NORM_EPS = 1e-6f;
constexpr int NWAVES = 8;
constexpr int NPHASE = 10;

constexpr size_t MiB = 1u << 20;
constexpr size_t WS_CTL = 0, CTL_ZERO_BYTES = 128 * 1024;
constexpr size_t WS_WIN = 1 * MiB;
constexpr size_t WS_WUQ = WS_WIN + (size_t)NIN * 1024 * 2;
constexpr size_t WS_WUKV = WS_WUQ + 768 * 384 * 2;
constexpr size_t WS_WBM = 12 * MiB, WS_WBL = 13 * MiB, WS_WOUT = 14 * MiB, WS_WUP = 16 * MiB, WS_WDN = 24 * MiB;
constexpr size_t WS_ROPE = 32 * MiB;
constexpr size_t WS_SSQ = 34 * MiB;
constexpr size_t WS_SSQ1 = WS_SSQ + 24 * (size_t)M * 4;
constexpr size_t WS_SSQ2 = WS_SSQ1 + 16 * (size_t)M * 4;
constexpr size_t WS_G32 = WS_SSQ2 + 16 * (size_t)M * 4;
constexpr size_t WS_UN = WS_G32 + (size_t)M * 16 * 4;
constexpr size_t WS_BL = WS_UN + 16 * 128 * 128 * 4;
constexpr size_t WS_ML = WS_BL + 16 * 128 * 4;
constexpr size_t WS_MP = WS_ML + 16 * 128 * 4;
static_assert(WS_MP + 16 * 128 * 4 <= 40 * MiB, "misc region");
static_assert(WS_WUKV + 1024 * 256 * 2 <= WS_WBM, "weights");
constexpr size_t WS_H0 = 40 * MiB, WS_HQK = 64 * MiB, WS_HVO = 96 * MiB, WS_HG = 128 * MiB;
constexpr size_t WS_R = 192 * MiB;
constexpr size_t WS_XN = WS_R, WS_UC = WS_R, WS_QC = WS_R + 16 * MiB, WS_KC = WS_R + 32 * MiB, WS_VTG = WS_R + 48 * MiB, WS_G1 = WS_R, WS_MERGED = WS_R + 32 * MiB, WS_X1B = WS_R;
constexpr size_t WS_ACT = 40 * MiB;
constexpr size_t WS_YA = 40 * MiB;
constexpr size_t WS_YM = WS_YA + 512 * 2;
constexpr size_t WS_END = 256 * MiB;
constexpr size_t DO_Q = 0, DO_KV = 24 * MiB, DO_KR = 56 * MiB;
constexpr int CW_BAR = 4096, CW_CNT = 16384, CW_P5 = 24576, CW_G2 = 24704, CW_G0 = 24768, CW_S3 = 24832, CW_G1 = 25920;
static_assert((CW_BAR + 3456) * 4 <= 128 * 1024 && (CW_CNT + 64 * 64) * 4 <= 128 * 1024, "control words inside the per-call memset");

__device__ __forceinline__ unsigned pk2(float lo, float hi) { f32x2_t v = {lo, hi}; bf16x2_t b = __builtin_convertvector(v, bf16x2_t); return __builtin_bit_cast(unsigned, b); }
__device__ __forceinline__ float bflo(unsigned w) { return __uint_as_float(w << 16); }
__device__ __forceinline__ float bfhi(unsigned w) { return __uint_as_float(w & 0xffff0000u); }
__device__ __forceinline__ float bf2f(bf16_t h) { return __uint_as_float((unsigned)h << 16); }
__device__ __forceinline__ float sigmoidf_(float x) { return __builtin_amdgcn_rcpf(1.f + __expf(-x)); }
__device__ __forceinline__ float dot4(f32x4 a) { return (a[0] * a[0] + a[1] * a[1]) + (a[2] * a[2] + a[3] * a[3]); }
#define LDS_WAIT() asm volatile("s_waitcnt lgkmcnt(0)" ::: "memory")
#define VM_WAIT() asm volatile("s_waitcnt vmcnt(0)" ::: "memory")

namespace pg8 {
#define PG8_LAS __attribute__((address_space(3)))
constexpr int BM = 256, BK = 64, HALF = 128, HTB = HALF * BK * 2, STAGE_BYTES = 8 * HTB, NXCD = 8, WGM = 8;
__host__ __device__ __forceinline__ int lds_byte(int r, int c) { const int st = (r >> 4) * 2 + (c >> 5), rr = r & 15, cc = c & 31, ob = rr * 64 + cc * 2; return st * 1024 + (ob ^ (((ob >> 9) & 1) << 5)); }
__host__ __device__ __forceinline__ void stage_rc(int b, int& R, int& C) { const int st = b / 1024, sb = b % 1024, swz = sb ^ (((sb >> 9) & 1) << 5); R = (st >> 1) * 16 + swz / 64; C = (st & 1) * 32 + (swz % 64) / 2; }
__host__ __device__ __forceinline__ int perm32(int rho) { const int n = rho >> 4, i = rho & 15; return 8 * (i >> 2) + 4 * n + (i & 3); }
struct Unit { int pm, pn; };
struct Gemm { const bf16_t* A; const bf16_t* Bt; int M, N, K, lda, ldb; };
struct StaticOrder {
    int nM, nN, nwg, G, c;
    __host__ __device__ void init(int M_, int N_, int G_, int c_) { nM = M_ / BM; nN = N_ / BM; nwg = nM * nN; G = G_; c = c_; }
    __host__ __device__ bool next(int i, Unit& u) const {
        const long L = (long)i * G + c; if (L >= nwg) return false;
        int wgid = (int)L; { const int q = nwg / NXCD, r = nwg % NXCD, xcd = wgid % NXCD, off = wgid / NXCD; wgid = (xcd < r ? xcd * (q + 1) : r * (q + 1) + (xcd - r) * q) + off; }
        const int nig = WGM * nN, gid = wgid / nig, fm = gid * WGM, gsz = (nM - fm) < WGM ? (nM - fm) : WGM;
        u.pm = fm + ((wgid % nig) % gsz); u.pn = (wgid % nig) / gsz; return true;
    }
};
template <class Epi, class Sched>
__device__ __forceinline__ void gemm_phase(PG8_LAS unsigned char* lds, const Gemm g, const Sched& S, const Epi& E) {
    const int tid = threadIdx.x, wid = __builtin_amdgcn_readfirstlane(tid >> 6), lane = tid & 63, wr = wid >> 2, wc = wid & 3, fr = lane & 15, fq = lane >> 4;
    const int K = g.K, nt = K / BK;
    unsigned voffA[2], voffB[2];
#pragma unroll
    for (int i = 0; i < 2; ++i) { int R, C; stage_rc(tid * 16 + i * 8192, R, C); const int Rb = (R & ~31) + perm32(R & 31);
        voffA[i] = (unsigned)(R * g.lda + C) * 2u; voffB[i] = (unsigned)(Rb * g.ldb + C) * 2u; }
    const size_t kstep = (size_t)(BK * 2);
    const size_t hstepA = (size_t)HALF * g.lda * 2, hstepB = (size_t)HALF * g.ldb * 2;
    const size_t tstepA = 2 * hstepA, tstepB = 2 * hstepB;
    const unsigned ldsw = (unsigned)wid * 1024u;
    const int aoff = lds_byte(wr * 64 + fr, fq * 8), boff = lds_byte(wc * 32 + fr, fq * 8);
#define PG8_SA(b, h) (((b) * 2 + (h)) * HTB)
#define PG8_SB(b, h) ((4 + (b) * 2 + (h)) * HTB)
#define PG8_STAGE(bufoff, gbase, voff) do { _Pragma("unroll") for (int _i = 0; _i < 2; ++_i) \
        __builtin_amdgcn_global_load_lds((const unsigned*)((const char*)(gbase) + (voff)[_i]), (PG8_LAS unsigned*)(lds + (bufoff) + ldsw + _i * 8192), 16, 0, 0); } while (0)
#define PG8_LDA(dst, b, h) do { _Pragma("unroll") for (int m = 0; m < 4; ++m) _Pragma("unroll") for (int k = 0; k < 2; ++k) dst[m][k] = *(const PG8_LAS bf16x8*)(lds + PG8_SA(b, h) + aoff + m * 2048 + k * 1024); } while (0)
#define PG8_LDB(dst, b, h) do { _Pragma("unroll") for (int n = 0; n < 2; ++n) _Pragma("unroll") for (int k = 0; k < 2; ++k) dst[n][k] = *(const PG8_LAS bf16x8*)(lds + PG8_SB(b, h) + boff + n * 2048 + k * 1024); } while (0)
#define PG8_MMA(ai, bj, At, Bt) do { __builtin_amdgcn_s_setprio(1); _Pragma("unroll") for (int m = 0; m < 4; ++m) _Pragma("unroll") for (int n = 0; n < 2; ++n) _Pragma("unroll") for (int k = 0; k < 2; ++k) \
        acc[ai][bj][m][n] = __builtin_amdgcn_mfma_f32_16x16x32_bf16(Bt[n][k], At[m][k], acc[ai][bj][m][n], 0, 0, 0); __builtin_amdgcn_s_setprio(0); } while (0)
#define PG8_WAIT_V(n) asm volatile("s_waitcnt vmcnt(" #n ")" ::: "memory")
#define PG8_WAIT_L(n) asm volatile("s_waitcnt lgkmcnt(" #n ")" ::: "memory")
#define PG8_BAR __builtin_amdgcn_s_barrier()
#define PG8_SCHED __builtin_amdgcn_sched_barrier(0)
    Unit cur, nxt; int ui = 0;
    if (!S.next(0, cur)) return;
    f32x4 acc[2][2][4][2];
#pragma unroll
    for (int a = 0; a < 2; ++a)
#pragma unroll
        for (int b = 0; b < 2; ++b)
#pragma unroll
            for (int m = 0; m < 4; ++m)
#pragma unroll
                for (int n = 0; n < 2; ++n) acc[a][b][m][n] = (f32x4){0.f, 0.f, 0.f, 0.f};
    bf16x8 At[4][2], B0[2][2], B1[2][2];
    const char* cA = (const char*)g.A + (size_t)cur.pm * tstepA; const char* cB = (const char*)g.Bt + (size_t)cur.pn * tstepB;
    PG8_STAGE(PG8_SB(0, 0), cB, voffB); PG8_STAGE(PG8_SB(0, 1), cB + hstepB, voffB); PG8_STAGE(PG8_SA(0, 0), cA, voffA); PG8_STAGE(PG8_SA(0, 1), cA + hstepA, voffA);
    if (wr == 1) PG8_BAR;
    PG8_WAIT_V(2); PG8_BAR;
    PG8_STAGE(PG8_SB(1, 0), cB + kstep, voffB); PG8_STAGE(PG8_SA(1, 0), cA + kstep, voffA); PG8_STAGE(PG8_SB(1, 1), cB + hstepB + kstep, voffB);
    PG8_WAIT_V(6); PG8_BAR;
    if constexpr (Epi::HAS_INIT) E.init(acc, cur, wr, wc, fr, fq);
    for (;;) {
        const bool has_next = S.next(ui + 1, nxt);
        const char* nA = has_next ? (const char*)g.A + (size_t)nxt.pm * tstepA : cA; const char* nB = has_next ? (const char*)g.Bt + (size_t)nxt.pn * tstepB : cB;
#pragma unroll 1
        for (int t = 0; t < nt; t += 2) {
            if constexpr (Epi::HAS_MID) { if (t == (nt >> 1)) { E.mid(acc, cur, wr, wc, fr, fq); PG8_SCHED; } }
            const bool last = (t == nt - 2);
            const char* a1 = cA + (size_t)(t + 1) * kstep;
            const char* a2 = last ? nA : cA + (size_t)(t + 2) * kstep; const char* b2 = last ? nB : cB + (size_t)(t + 2) * kstep;
            const char* a3 = a2 + kstep; const char* b3 = b2 + kstep;
            PG8_LDB(B0, 0, 0); PG8_LDB(B1, 0, 1); PG8_SCHED; PG8_LDA(At, 0, 0); PG8_STAGE(PG8_SA(1, 1), a1 + hstepA, voffA);
            PG8_WAIT_V(8); PG8_WAIT_L(0); PG8_BAR; PG8_MMA(0, 0, At, B0); PG8_MMA(0, 1, At, B1); PG8_BAR; PG8_SCHED;
            PG8_LDA(At, 0, 1); PG8_STAGE(PG8_SB(0, 0), b2, voffB); PG8_STAGE(PG8_SB(0, 1), b2 + hstepB, voffB); PG8_STAGE(PG8_SA(0, 0), a2, voffA);
            PG8_WAIT_V(8); PG8_WAIT_L(0); PG8_BAR; PG8_MMA(1, 0, At, B0); PG8_MMA(1, 1, At, B1); PG8_BAR; PG8_SCHED;
            PG8_LDB(B0, 1, 0); PG8_LDB(B1, 1, 1); PG8_SCHED; PG8_LDA(At, 1, 0); PG8_STAGE(PG8_SA(0, 1), a2 + hstepA, voffA);
            PG8_WAIT_V(8); PG8_WAIT_L(0); PG8_BAR; PG8_MMA(0, 0, At, B0); PG8_MMA(0, 1, At, B1); PG8_BAR; PG8_SCHED;
            PG8_LDA(At, 1, 1); PG8_STAGE(PG8_SB(1, 0), b3, voffB); PG8_STAGE(PG8_SB(1, 1), b3 + hstepB, voffB); PG8_STAGE(PG8_SA(1, 0), a3, voffA);
            PG8_WAIT_V(8); PG8_WAIT_L(0); PG8_BAR; PG8_MMA(1, 0, At, B0); PG8_MMA(1, 1, At, B1); PG8_BAR; PG8_SCHED;
        }
        if (wr == 0) PG8_BAR;
        if constexpr (Epi::HAS_PREP) { E.prep(cur, lds + STAGE_BYTES + 1024, tid); PG8_WAIT_L(0); PG8_BAR; }
        if constexpr (Epi::FINAL) E.fused(acc, cur, wr, wc, fr, fq, lds + STAGE_BYTES + 1024, tid);
        else E(acc, cur, wr, wc, fr, fq, lds + STAGE_BYTES + 1024);
        if (!has_next) break;
#pragma unroll
        for (int a = 0; a < 2; ++a)
#pragma unroll
            for (int b = 0; b < 2; ++b)
#pragma unroll
                for (int m = 0; m < 4; ++m)
#pragma unroll
                    for (int n = 0; n < 2; ++n) acc[a][b][m][n] = (f32x4){0.f, 0.f, 0.f, 0.f};
        cur = nxt; cA = nA; cB = nB; ++ui;
        if constexpr (Epi::HAS_INIT) E.init(acc, cur, wr, wc, fr, fq);
        if (wr == 1) PG8_BAR;
    }
    PG8_WAIT_V(0);
    PG8_BAR;
#undef PG8_SA
#undef PG8_SB
#undef PG8_STAGE
#undef PG8_LDA
#undef PG8_LDB
#undef PG8_MMA
#undef PG8_WAIT_V
#undef PG8_WAIT_L
#undef PG8_BAR
#undef PG8_SCHED
}
}

#define EPI_ROWS_BEGIN  _Pragma("unroll") for (int ai = 0; ai < 2; ++ai) _Pragma("unroll") for (int m = 0; m < 4; ++m) { const int row = row0 + ai * 128 + m * 16;
#define EPI_ROWS_END    asm volatile("" ::: "memory"); }
#define EPI_HALF_BEGIN  _Pragma("unroll") for (int ai = 0; ai < 2; ++ai) {
#define EPI_HALF_END    asm volatile("" ::: "memory"); }
#define EPI_M_LOOP      _Pragma("unroll") for (int m = 0; m < 4; ++m) { const int row = row0 + ai * 128 + m * 16;
__device__ __forceinline__ u32x4 pack8(f32x4 v0, f32x4 v1) { u32x4 w; w.x = pk2(v0[0], v0[1]); w.y = pk2(v0[2], v0[3]); w.z = pk2(v1[0], v1[1]); w.w = pk2(v1[2], v1[3]); return w; }
__device__ __forceinline__ void unpack8(u32x4 w, f32x4& v0, f32x4& v1) { v0 = (f32x4){bflo(w.x), bfhi(w.x), bflo(w.y), bfhi(w.y)}; v1 = (f32x4){bflo(w.z), bfhi(w.z), bflo(w.w), bfhi(w.w)}; }
typedef f32x4 acc_t[2][2][4][2];
__device__ __forceinline__ void st8wt(void* p, u32x2 v) { asm volatile("global_store_dwordx2 %0, %1, off sc1" :: "v"(p), "v"(v) : "memory"); }
__device__ __forceinline__ void st16wt(void* p, u32x4 v) { asm volatile("global_store_dwordx4 %0, %1, off sc1\n\ts_nop 2" :: "v"(p), "v"(v) : "memory"); }

struct EpiIn {
    static constexpr bool HAS_PREP = false, FINAL = false, HAS_MID = false, HAS_INIT = false;
    bf16_t *H0, *HQK, *HVO, *HG; float* SSQ; float* G32;
    __device__ __forceinline__ void operator()(const acc_t& acc, const pg8::Unit& u, int wr, int wc, int fr, int fq, LAS unsigned char* tab) const {
        bf16_t* base; int ld, ct; const int pn = u.pn;
        if (pn < 3) { base = H0; ld = 768; ct = pn * 256; }
        else if (pn < 7) { base = HQK; ld = 1024; ct = (pn - 3) * 256; }
        else if (pn < 11) { base = HVO; ld = 1024; ct = (pn - 7) * 256; }
        else { base = HG; ld = 2048; ct = (pn - 11) * 256; }
        const int row0 = u.pm * 256 + wr * 64 + fr, col0 = ct + wc * 32 + 8 * fq;
        EPI_ROWS_BEGIN
            bf16_t* rp = base + (size_t)row * ld + col0;
#pragma unroll
            for (int bj = 0; bj < 2; ++bj) {
                const f32x4 v0 = acc[ai][bj][m][0], v1 = acc[ai][bj][m][1];
                *(u32x4*)(rp + bj * 128) = pack8(v0, v1);
                if (pn < 3) {
                    float s = dot4(v0) + dot4(v1); s += __shfl_xor(s, 16); s += __shfl_xor(s, 32);
                    if (fq == 0 && !(pn == 2 && bj == 1)) SSQ[(size_t)((pn * 2 + bj) * 4 + wc) * M + row] = s;
                    if (pn == 2 && bj == 1 && wc == 1 && fq < 2) { float* gp = G32 + (size_t)row * 16 + 8 * fq; *(f32x4*)gp = v0; *(f32x4*)(gp + 4) = v1; }
                }
            }
        EPI_ROWS_END
    }
};
struct EpiQ {
    static constexpr bool HAS_PREP = true, FINAL = false, HAS_MID = false, HAS_INIT = false;
    bf16_t* Q; const float* SSQ; const float* ROPE;
    __device__ __forceinline__ void prep(const pg8::Unit& u, LAS unsigned char* tab, int tid) const {
        if (tid < 256) { const int row = u.pm * 256 + tid; float ss = 0.f;
#pragma unroll
            for (int p = 0; p < 12; ++p) ss += SSQ[(size_t)p * M + row];
            ((LAS float*)tab)[tid] = rsqrtf(ss * (1.f / 384.f) + NORM_EPS) * (0.10206207261596575f * 1.4426950408889634f); }
    }
    __device__ __forceinline__ void operator()(const acc_t& acc, const pg8::Unit& u, int wr, int wc, int fr, int fq, LAS unsigned char* tab) const {
        const int row0 = u.pm * 256 + wr * 64 + fr, col0 = u.pn * 256 + wc * 32 + 8 * fq;
        EPI_HALF_BEGIN
            f32x4 rc[4][2], rs[4][2];
            EPI_M_LOOP
#pragma unroll
                for (int bj = 0; bj < 2; ++bj) { const int d = (col0 + bj * 128) % 96; rc[m][bj] = f32x4{}; rs[m][bj] = f32x4{};
                    if (d >= 64) { const int j0 = (d - 64) >> 1; rc[m][bj] = *(const f32x4*)(ROPE + (size_t)row * 32 + j0); rs[m][bj] = *(const f32x4*)(ROPE + (size_t)row * 32 + 16 + j0); } } }
            EPI_M_LOOP
                const float rstd = ((const LAS float*)tab)[row - u.pm * 256];
#pragma unroll
                for (int bj = 0; bj < 2; ++bj) {
                    const int col = col0 + bj * 128, d = col % 96;
                    f32x4 v0 = acc[ai][bj][m][0] * rstd, v1 = acc[ai][bj][m][1] * rstd;
                    if (d >= 64) { const f32x4 c = rc[m][bj], s = rs[m][bj]; const f32x4 o0 = v0 * c - v1 * s, o1 = v1 * c + v0 * s; v0 = o0; v1 = o1; }
                    *(u32x4*)(Q + (size_t)row * 768 + col) = pack8(v0, v1);
                } }
        EPI_HALF_END
    }
};
struct EpiKV {
    static constexpr bool HAS_PREP = true, FINAL = false, HAS_MID = false, HAS_INIT = false;
    bf16_t* KV; const float* SSQ;
    __device__ __forceinline__ void prep(const pg8::Unit& u, LAS unsigned char* tab, int tid) const {
        if (tid < 256) { const int row = u.pm * 256 + tid; float ss = 0.f;
#pragma unroll
            for (int p = 12; p < 20; ++p) ss += SSQ[(size_t)p * M + row];
            ((LAS float*)tab)[tid] = rsqrtf(ss * (1.f / 256.f) + NORM_EPS); }
    }
    __device__ __forceinline__ void operator()(const acc_t& acc, const pg8::Unit& u, int wr, int wc, int fr, int fq, LAS unsigned char* tab) const {
        const int row0 = u.pm * 256 + wr * 64 + fr, col0 = u.pn * 256 + wc * 32 + 8 * fq;
        EPI_ROWS_BEGIN
            const float rstd = ((const LAS float*)tab)[row - u.pm * 256];
#pragma unroll
            for (int bj = 0; bj < 2; ++bj) {
                const int col = col0 + bj * 128;
                *(u32x4*)(KV + (size_t)row * 1024 + col) = pack8(acc[ai][bj][m][0] * rstd, acc[ai][bj][m][1] * rstd);
            }
        EPI_ROWS_END
    }
};
struct EpiMergeF {
    static constexpr bool HAS_PREP = false, FINAL = false, HAS_MID = true, HAS_INIT = false;
    bf16_t* MG; const bf16_t* HG;
    __device__ __forceinline__ void mid(acc_t& acc, const pg8::Unit& u, int wr, int wc, int fr, int fq) const {
        int lane_ = threadIdx.x & 63; asm volatile("" : "+v"(lane_));
        const int row0 = u.pm * 256 + wr * 64 + (lane_ & 15), col0 = u.pn * 256 + wc * 32 + 8 * (lane_ >> 4);
#pragma unroll
        for (int ai = 0; ai < 2; ++ai)
#pragma unroll
            for (int mp = 0; mp < 2; ++mp) {
                u32x4 ga[2][2], gb[2][2];
#pragma unroll
                for (int mm = 0; mm < 2; ++mm) { const int row = row0 + ai * 128 + (2 * mp + mm) * 16;
#pragma unroll
                    for (int bj = 0; bj < 2; ++bj) { ga[mm][bj] = __builtin_nontemporal_load((const u32x4*)(HG + (size_t)row * 2048 + col0 + bj * 128)); gb[mm][bj] = *(const u32x4*)(HG + (size_t)row * 2048 + 1024 + col0 + bj * 128); } }
#pragma unroll
                for (int mm = 0; mm < 2; ++mm) { const int m = 2 * mp + mm;
#pragma unroll
                    for (int bj = 0; bj < 2; ++bj) { f32x4 a0, a1, b0, b1; unpack8(ga[mm][bj], a0, a1); unpack8(gb[mm][bj], b0, b1);
#pragma unroll
                        for (int e = 0; e < 4; ++e) {
                            acc[ai][bj][m][0][e] *= (1.f + __expf(fminf(-b0[e], 60.f))) * __builtin_amdgcn_rcpf(1.f + __expf(fminf(-a0[e], 60.f)));
                            acc[ai][bj][m][1][e] *= (1.f + __expf(fminf(-b1[e], 60.f))) * __builtin_amdgcn_rcpf(1.f + __expf(fminf(-a1[e], 60.f))); } } }
                asm volatile("" ::: "memory");
            }
    }
    __device__ __forceinline__ void operator()(const acc_t& acc, const pg8::Unit& u, int wr, int wc, int fr, int fq, LAS unsigned char* tab) const {
        const int row0 = u.pm * 256 + wr * 64 + fr, col0 = u.pn * 256 + wc * 32 + 8 * fq;
        EPI_HALF_BEGIN
            u32x4 gb[4][2];
            EPI_M_LOOP
#pragma unroll
                for (int bj = 0; bj < 2; ++bj) gb[m][bj] = __builtin_nontemporal_load((const u32x4*)(HG + (size_t)row * 2048 + 1024 + col0 + bj * 128)); }
            EPI_M_LOOP
#pragma unroll
                for (int bj = 0; bj < 2; ++bj) { f32x4 b0, b1; unpack8(gb[m][bj], b0, b1);
                    f32x4 v0 = acc[ai][bj][m][0], v1 = acc[ai][bj][m][1];
#pragma unroll
                    for (int e = 0; e < 4; ++e) { v0[e] *= __builtin_amdgcn_rcpf(1.f + __expf(fminf(-b0[e], 60.f))); v1[e] *= __builtin_amdgcn_rcpf(1.f + __expf(fminf(-b1[e], 60.f))); }
                    *(u32x4*)(MG + (size_t)row * 1024 + col0 + bj * 128) = pack8(v0, v1);
                } }
        EPI_HALF_END
    }
};
struct EpiRes {
    static constexpr bool HAS_PREP = false, FINAL = false, HAS_MID = false, HAS_INIT = true;
    const float* X; float* Y; bf16_t* YB; float* SSQ; bool early;
    __device__ __forceinline__ void init(acc_t& acc, const pg8::Unit& u, int wr, int wc, int fr, int fq) const {
        if (!early) return;
        int lane_ = threadIdx.x & 63; asm volatile("" : "+v"(lane_));
        const int row0 = u.pm * 256 + wr * 64 + (lane_ & 15), col0 = u.pn * 256 + wc * 32 + 8 * (lane_ >> 4);
#pragma unroll
        for (int ai = 0; ai < 2; ++ai)
#pragma unroll
            for (int m = 0; m < 4; ++m) { const int row = row0 + ai * 128 + m * 16;
#pragma unroll
                for (int bj = 0; bj < 2; ++bj) { const size_t off = (size_t)row * 1024 + col0 + bj * 128;
                    acc[ai][bj][m][0] = __builtin_nontemporal_load((const f32x4*)(X + off)); acc[ai][bj][m][1] = __builtin_nontemporal_load((const f32x4*)(X + off + 4)); } }
    }
    __device__ __forceinline__ void operator()(const acc_t& acc, const pg8::Unit& u, int wr, int wc, int fr, int fq, LAS unsigned char* tab) const {
        const int row0 = u.pm * 256 + wr * 64 + fr, col0 = u.pn * 256 + wc * 32 + 8 * fq;
        EPI_HALF_BEGIN
            f32x4 xa[4][2][2];
            EPI_M_LOOP
#pragma unroll
                for (int bj = 0; bj < 2; ++bj) { const size_t off = (size_t)row * 1024 + col0 + bj * 128; xa[m][bj][0] = f32x4{}; xa[m][bj][1] = f32x4{};
                    if (!early) { xa[m][bj][0] = __builtin_nontemporal_load((const f32x4*)(X + off)); xa[m][bj][1] = __builtin_nontemporal_load((const f32x4*)(X + off + 4)); } } }
            EPI_M_LOOP
                float s = 0.f;
#pragma unroll
                for (int bj = 0; bj < 2; ++bj) {
                    const size_t off = (size_t)row * 1024 + col0 + bj * 128;
                    const f32x4 v0 = xa[m][bj][0] + acc[ai][bj][m][0], v1 = xa[m][bj][1] + acc[ai][bj][m][1];
                    if (Y) { *(f32x4*)(Y + off) = v0; *(f32x4*)(Y + off + 4) = v1; }
                    if (YB) *(u32x4*)(YB + off) = pack8(v0, v1);
                    s += dot4(v0) + dot4(v1);
                }
                s += __shfl_xor(s, 16); s += __shfl_xor(s, 32);
                if (fq == 0) SSQ[(size_t)(u.pn * 4 + wc) * M + row] = s; }
        EPI_HALF_END
    }
};
struct EpiUp {
    static constexpr bool HAS_PREP = true, FINAL = false, HAS_MID = false, HAS_INIT = false;
    bf16_t* ACT; const float* SSQ1;
    __device__ __forceinline__ void prep(const pg8::Unit& u, LAS unsigned char* tab, int tid) const {
        if (tid < 256) { const int row = u.pm * 256 + tid; float ss = 0.f;
#pragma unroll
            for (int p = 0; p < 16; ++p) ss += SSQ1[(size_t)p * M + row];
            ((LAS float*)tab)[tid] = rsqrtf(ss * (1.f / 1024.f) + NORM_EPS); }
    }
    __device__ __forceinline__ void operator()(const acc_t& acc, const pg8::Unit& u, int wr, int wc, int fr, int fq, LAS unsigned char* tab) const {
        const int row0 = u.pm * 256 + wr * 64 + fr, col0 = u.pn * 256 + wc * 32 + 8 * fq;
        EPI_ROWS_BEGIN
            const float rstd = ((const LAS float*)tab)[row - u.pm * 256];
#pragma unroll
            for (int bj = 0; bj < 2; ++bj) {
                f32x4 v0 = acc[ai][bj][m][0] * rstd, v1 = acc[ai][bj][m][1] * rstd;
#pragma unroll
                for (int e = 0; e < 4; ++e) { const float a = fmaxf(v0[e], 0.f), b = fmaxf(v1[e], 0.f); v0[e] = a * a; v1[e] = b * b; }
                st16wt(ACT + (size_t)row * DFF + col0 + bj * 128, pack8(v0, v1));
            }
        EPI_ROWS_END
    }
};

struct EpiFinal {
    static constexpr bool HAS_PREP = false, FINAL = true, HAS_MID = false, HAS_INIT = false;
    const bf16_t* XB; float* Y; const float* gfin; float* SLAB; unsigned* cnt;
    __device__ __forceinline__ void operator()(const acc_t&, const pg8::Unit&, int, int, int, int, LAS unsigned char*) const {}
    __device__ __forceinline__ void fused(acc_t& acc, const pg8::Unit& u, int wr, int wc, int fr, int fq, LAS unsigned char* tab, int tid) const {
        LAS float* PT = (LAS float*)tab;
        LAS float* RS = PT + 1024;
        const int row0 = u.pm * 256 + wr * 64 + fr, col0 = u.pn * 256 + wc * 32 + 8 * fq;
        EPI_HALF_BEGIN
            u32x4 xb[4][2];
            EPI_M_LOOP
#pragma unroll
                for (int bj = 0; bj < 2; ++bj) xb[m][bj] = __builtin_nontemporal_load((const u32x4*)(XB + (size_t)row * 1024 + col0 + bj * 128)); }
            EPI_M_LOOP
                float s = 0.f;
#pragma unroll
                for (int bj = 0; bj < 2; ++bj) {
                    { f32x4 x0, x1; unpack8(xb[m][bj], x0, x1); acc[ai][bj][m][0] += x0; acc[ai][bj][m][1] += x1; }
                    s += dot4(acc[ai][bj][m][0]) + dot4(acc[ai][bj][m][1]);
                }
                s += __shfl_xor(s, 16); s += __shfl_xor(s, 32);
                if (fq == 0) PT[(row - u.pm * 256) * 4 + wc] = s; }
        EPI_HALF_END
        asm volatile("s_waitcnt lgkmcnt(0)" ::: "memory"); __builtin_amdgcn_s_barrier(); asm volatile("" ::: "memory");
        if (tid < 256) { const f32x4 p = *(const LAS f32x4*)(PT + tid * 4);
            __hip_atomic_store(SLAB + (size_t)u.pn * M + u.pm * 256 + tid, (p[0] + p[1]) + (p[2] + p[3]), __ATOMIC_RELAXED, __HIP_MEMORY_SCOPE_AGENT); }
        asm volatile("s_waitcnt vmcnt(0)" ::: "memory"); __builtin_amdgcn_s_barrier(); asm volatile("" ::: "memory");
        if (tid == 0) __hip_atomic_fetch_add(cnt + 64 * u.pm, 1u, __ATOMIC_RELAXED, __HIP_MEMORY_SCOPE_AGENT);
        if (tid < 64) { unsigned spins = 0;
            while (__hip_atomic_load(cnt + 64 * u.pm, __ATOMIC_RELAXED, __HIP_MEMORY_SCOPE_AGENT) < 4u) { __builtin_amdgcn_s_sleep(2); if (++spins > (1u << 20)) break; } }
        __builtin_amdgcn_s_barrier(); asm volatile("" ::: "memory");
        if (tid < 256) { float ss = 0.f;
#pragma unroll
            for (int t = 0; t < 4; ++t) ss += __hip_atomic_load(SLAB + (size_t)t * M + u.pm * 256 + tid, __ATOMIC_RELAXED, __HIP_MEMORY_SCOPE_AGENT);
            RS[tid] = rsqrtf(ss * (1.f / 1024.f) + NORM_EPS); }
        asm volatile("s_waitcnt lgkmcnt(0)" ::: "memory"); __builtin_amdgcn_s_barrier(); asm volatile("" ::: "memory");
        f32x4 gf[2][2];
#pragma unroll
        for (int bj = 0; bj < 2; ++bj) { gf[bj][0] = *(const f32x4*)(gfin + col0 + bj * 128); gf[bj][1] = *(const f32x4*)(gfin + col0 + bj * 128 + 4); }
        EPI_ROWS_BEGIN
            const float rstd = RS[row - u.pm * 256];
#pragma unroll
            for (int bj = 0; bj < 2; ++bj) {
                const size_t off = (size_t)row * 1024 + col0 + bj * 128;
                *(f32x4*)(Y + off) = acc[ai][bj][m][0] * rstd * gf[bj][0]; *(f32x4*)(Y + off + 4) = acc[ai][bj][m][1] * rstd * gf[bj][1];
            }
        EPI_ROWS_END
    }
};

namespace att {
constexpr int NW = 8, QBLK = 32, KVBLK = 64;
constexpr float QSCALE = 0.10206207261596575f * 1.4426950408889634f;
constexpr float THRL = 8.f;
constexpr int LDQ = 768, LDKV = 1024, LDKR = 32, LDO = 1024;
constexpr int SLOTB = 12288, LDS_K = 0, LDS_V = 3 * SLOTB, SHM_ATTN = 6 * SLOTB;
#define SBAR() __builtin_amdgcn_sched_barrier(0)
#define WAIT_BAR(N) asm volatile("s_waitcnt vmcnt(" #N ") lgkmcnt(0)\n\ts_barrier" ::: "memory")
__device__ __forceinline__ void glds16(const void* gsrc, unsigned lds_dst) { unsigned keep;
  asm volatile("s_mov_b32 %0, m0\n\ts_mov_b32 m0, %2\n\ts_nop 0\n\tglobal_load_lds_dwordx4 %1, off\n\ts_mov_b32 m0, %0" : "=&s"(keep) : "v"(gsrc), "s"(lds_dst) : "memory"); }
typedef LAS const char* lds_cptr;
typedef short v4i16_t __attribute__((ext_vector_type(4)));
__device__ __forceinline__ void kload2(bf16x8* kf, lds_cptr kp, int j) { kf[2 * j] = *(const LAS bf16x8*)(kp + j * 2048); kf[2 * j + 1] = *(const LAS bf16x8*)(kp + j * 2048 + 512); }
__device__ __forceinline__ s16x4 vtr(lds_cptr p) { return __builtin_bit_cast(s16x4, __builtin_amdgcn_ds_read_tr16_b64_v4i16((LAS v4i16_t*)p)); }
__device__ __forceinline__ unsigned cvtpk_s(float lo, float hi) { typedef float f2_t __attribute__((ext_vector_type(2))); typedef __bf16 b2_t __attribute__((ext_vector_type(2)));
  f2_t v = {lo, hi}; b2_t b = __builtin_convertvector(v, b2_t); return __builtin_bit_cast(unsigned, b); }
#define MX3(a, b, c) __builtin_fmaxf(__builtin_fmaxf((a), (b)), (c))
__device__ __forceinline__ float rowmax(const f32x16& p0, const f32x16& p1) {
  float a = MX3(p0[0], p0[1], p1[0]), b = MX3(p0[2], p0[3], p1[1]); a = MX3(a, p1[2], p1[3]);
#pragma unroll
  for (int r = 4; r < 16; r += 4) { a = MX3(a, p0[r], p0[r + 1]); b = MX3(b, p0[r + 2], p0[r + 3]); a = MX3(a, p1[r], p1[r + 1]); b = MX3(b, p1[r + 2], p1[r + 3]); }
  float m = __builtin_fmaxf(a, b); auto rr = __builtin_amdgcn_permlane32_swap(__float_as_uint(m), __float_as_uint(m), false, false);
  return __builtin_fmaxf(__uint_as_float(rr[0]), __uint_as_float(rr[1])); }
#define MFMA(a, b, c) __builtin_amdgcn_mfma_f32_32x32x16_bf16(a, b, c, 0, 0, 0)
__device__ __forceinline__ void attn_unit(const bf16_t* __restrict__ Qb, const bf16_t* __restrict__ Kh, const bf16_t* __restrict__ KRb, bf16_t* __restrict__ Ob, LAS unsigned char* shm) {
  int tid = threadIdx.x; asm volatile("" : "+v"(tid));
  const int lane = tid & 63, r32 = lane & 31, hi = lane >> 5; const int wid = __builtin_amdgcn_readfirstlane(tid >> 6);
  const bool w3 = wid < 4;
  const unsigned lds0 = (unsigned)(uintptr_t)shm;
  const bf16_t* ksrc = Kh + (long)lane * LDKV + wid * 8;
  const bf16_t* rsrc = KRb + (long)lane * LDKR + (wid & 3) * 8;
  const bf16_t* vsrc = Kh + 64 + (long)(16 * (wid & 3) + (lane >> 2)) * LDKV + (wid >> 2) * 32 + (lane & 3) * 8;
  const unsigned kdst = lds0 + LDS_K + wid * 1024, rdst = lds0 + LDS_K + (8 + (wid & 3)) * 1024, vdst = lds0 + LDS_V + wid * 1024;
#define DMA_K(t, slot) do { glds16(ksrc + (long)(t) * KVBLK * LDKV, (unsigned)__builtin_amdgcn_readfirstlane(kdst + (slot))); \
    if (w3) glds16(rsrc + (long)(t) * KVBLK * LDKR, (unsigned)__builtin_amdgcn_readfirstlane(rdst + (slot))); } while (0)
#define DMA_V(t, slot) glds16(vsrc + (long)(t) * KVBLK * LDKV, (unsigned)__builtin_amdgcn_readfirstlane(vdst + (slot)))
#define WAITB(NHI, NLO) do { if (w3) { WAIT_BAR(NHI); } else { WAIT_BAR(NLO); } } while (0)
  const lds_cptr shm3 = (lds_cptr)shm; const lds_cptr kp0 = shm3 + LDS_K + hi * 1024 + r32 * 16;
  const lds_cptr vp0 = shm3 + LDS_V + ((lane >> 4) & 1) * 32 + (lane & 3) * 8 + (4 * hi + ((lane & 15) >> 2)) * 64;
  constexpr int NT = SEQ / KVBLK;
  DMA_K(0, 0); DMA_V(0, 0); DMA_K(1, SLOTB);
  bf16x8 qr[6]; bf16x8 kf[12];
  { const bf16_t* Qw = Qb + (long)(wid * QBLK + r32) * LDQ + hi * 8;
#pragma unroll
    for (int d0 = 0; d0 < 6; ++d0) qr[d0] = *reinterpret_cast<const bf16x8*>(Qw + d0 * 16); }
  float mhat = 0.f, l_reg = 0.f, fres = 1.f; f32x16 o[2]; o[0] = f32x16{}; o[1] = f32x16{}; f32x16 negm = f32x16{}; asm volatile("" : "+v"(negm));
  bool resc = false;
#define RESC() do { if (resc) { _Pragma("unroll") for (int d_ = 0; d_ < 2; ++d_) _Pragma("unroll") for (int r = 0; r < 16; ++r) o[d_][r] *= fres; } } while (0)
  f32x16 pA0, pA1, pB0, pB1;
  int sl_prev = 0, sl_cur = 0, sl_next = SLOTB;
#define ROT() do { sl_prev = sl_cur; sl_cur = sl_next; sl_next = (sl_next == 2 * SLOTB) ? 0 : sl_next + SLOTB; } while (0)
  DMA_K(2, 2 * SLOTB);
  WAITB(5, 3);
#pragma unroll
  for (int j = 0; j < 6; ++j) kload2(kf, kp0, j);
#pragma unroll
  for (int j = 0; j < 6; ++j) { pA0 = MFMA(kf[2 * j], qr[j], j ? pA0 : negm); pA1 = MFMA(kf[2 * j + 1], qr[j], j ? pA1 : negm); }
  { const float rm = rowmax(pA0, pA1); mhat = rm;
#pragma unroll
    for (int r = 0; r < 16; ++r) { pA0[r] = __builtin_amdgcn_exp2f(pA0[r] - rm); pA1[r] = __builtin_amdgcn_exp2f(pA1[r] - rm); }
#pragma unroll
    for (int r = 0; r < 16; ++r) negm[r] = -mhat;
    asm volatile("" : "+v"(negm)); }
  WAIT_BAR(0);
  DMA_K(3, 0); DMA_V(1, SLOTB);
  ROT();
#pragma unroll
  for (int j = 0; j < 6; ++j) kload2(kf, kp0 + sl_cur, j);
  WAITB(3, 2);
  s16x4 vlo[8], vhi[8]; u32x4 pw0, pw1, pw2, pw3;
#define PKW(P, B) cvtpk_s(P[B], P[(B) + 1])
#define PAF(k) __builtin_bit_cast(bf16x8, pw##k)
#define VFR(i) (bf16x8){vlo[i][0], vlo[i][1], vlo[i][2], vlo[i][3], vhi[i][0], vhi[i][1], vhi[i][2], vhi[i][3]}
#define PIN(x) asm volatile("" : "+v"(x))
#define EX(v) __builtin_amdgcn_exp2f(v)
#define VRD(i) do { vlo[i] = vtr(vp_ + (((i) >> 2) * 4096 + ((i) & 3) * 1024)); vhi[i] = vtr(vp_ + (((i) >> 2) * 4096 + ((i) & 3) * 1024 + 512)); } while (0)
#define KRD(G, j) do { if (G) { kload2(kf, kp0 + sl_next, j); SBAR(); } } while (0)
#define GA3(MF, A0, A1, A2, W0, PW) do { MF; sacc += A0; sacc += A1; sacc += A2; PIN(sacc); W0; PIN(PW); SBAR(); } while (0)
#define GA2(MF, A0, A1, W0, W1, PW) do { MF; sacc += A0; sacc += A1; PIN(sacc); W0; W1; PIN(PW); SBAR(); } while (0)
#define GA2S(MF, A0, A1, W0, PW) do { MF; sacc += A0; sacc += A1; PIN(sacc); W0; PIN(PW); SBAR(); } while (0)
#define GAPB(MF, X, B) do { MF; X[B] = EX(X[B]); X[(B) + 1] = EX(X[(B) + 1]); X[(B) + 2] = EX(X[(B) + 2]); X[(B) + 3] = EX(X[(B) + 3]); PIN(X); SBAR(); } while (0)
#define STEP(C0, C1, P0, P1, t, GK, GV, GL) do { SBAR(); \
    const lds_cptr vp_ = vp0 + sl_prev; \
    VRD(0); SBAR(); float sacc = (P0[0] + P0[1]); \
                    GA3(C0 = MFMA(kf[0], qr[0], negm),  P0[2], P0[3], P0[4],      pw0[0] = PKW(P0, 0), pw0); \
    VRD(4); SBAR(); GA3(C1 = MFMA(kf[1], qr[0], negm),  P0[5], P0[6], P0[7],      pw0[1] = PKW(P0, 2), pw0); \
                    GA2(C0 = MFMA(kf[2], qr[1], C0),    P0[8], P0[9],             pw0[2] = PKW(P0, 4), pw0[3] = PKW(P0, 6), pw0); \
    VRD(1); SBAR(); GA3(C1 = MFMA(kf[3], qr[1], C1),    P0[10], P0[11], P0[12],   pw1[0] = PKW(P0, 8), pw1); \
    VRD(5); SBAR(); GA3(C0 = MFMA(kf[4], qr[2], C0),    P0[13], P0[14], P0[15],   pw1[1] = PKW(P0, 10), pw1); \
                    GA2(C1 = MFMA(kf[5], qr[2], C1),    P1[0], P1[1],             pw1[2] = PKW(P0, 12), pw1[3] = PKW(P0, 14), pw1); \
    VRD(2); SBAR(); GA3(C0 = MFMA(kf[6], qr[3], C0),    P1[2], P1[3], P1[4],      pw2[0] = PKW(P1, 0), pw2); \
    VRD(6); SBAR(); GA3(C1 = MFMA(kf[7], qr[3], C1),    P1[5], P1[6], P1[7],      pw2[1] = PKW(P1, 2), pw2); \
                    GA2(C0 = MFMA(kf[8], qr[4], C0),    P1[8], P1[9],             pw2[2] = PKW(P1, 4), pw2[3] = PKW(P1, 6), pw2); \
    VRD(3); SBAR(); GA2S(C1 = MFMA(kf[9], qr[4], C1),   P1[10], P1[11],           pw3[0] = PKW(P1, 8), pw3); \
    VRD(7); SBAR(); GA2S(C0 = MFMA(kf[10], qr[5], C0),  P1[12], P1[13],           pw3[1] = PKW(P1, 10), pw3); \
                    GA2(C1 = MFMA(kf[11], qr[5], C1),   P1[14], P1[15],           pw3[2] = PKW(P1, 12), pw3[3] = PKW(P1, 14), pw3); \
    l_reg += sacc; \
    if (GK) { DMA_K((t) + 3, sl_cur); } if (GV) { DMA_V((t) + 1, sl_next); } \
    { const float rm = rowmax(C0, C1); resc = false; \
      if (__builtin_expect(__any(rm > THRL), 0)) { const float dl = __builtin_fmaxf(rm, 0.f); mhat += dl; \
        _Pragma("unroll") for (int r = 0; r < 16; ++r) { C0[r] -= dl; C1[r] -= dl; } \
        _Pragma("unroll") for (int r = 0; r < 16; ++r) negm[r] = -mhat; \
        asm volatile("" : "+v"(negm)); \
        fres = __builtin_amdgcn_exp2f(-dl); l_reg *= fres; resc = true; } } \
    SBAR(); \
                GAPB(o[0] = MFMA(VFR(0), PAF(0), o[0]), C0, 0); \
    KRD(GL, 0); GAPB(o[1] = MFMA(VFR(4), PAF(0), o[1]), C0, 4); \
    KRD(GL, 1); GAPB(o[0] = MFMA(VFR(1), PAF(1), o[0]), C0, 8); \
    KRD(GL, 2); GAPB(o[1] = MFMA(VFR(5), PAF(1), o[1]), C0, 12); \
    KRD(GL, 3); GAPB(o[0] = MFMA(VFR(2), PAF(2), o[0]), C1, 0); \
    KRD(GL, 4); GAPB(o[1] = MFMA(VFR(6), PAF(2), o[1]), C1, 4); \
    KRD(GL, 5); GAPB(o[0] = MFMA(VFR(3), PAF(3), o[0]), C1, 8); \
                GAPB(o[1] = MFMA(VFR(7), PAF(3), o[1]), C1, 12); \
    } while (0)
  int t = 1;
  for (; t + 5 < NT; t += 2) {
    STEP(pB0, pB1, pA0, pA1, t, true, true, true);     WAITB(3, 2); RESC(); ROT();
    STEP(pA0, pA1, pB0, pB1, t + 1, true, true, true); WAITB(3, 2); RESC(); ROT();
  }
#define ENDW(tt) do { if ((tt) + 3 < NT) { WAITB(3, 2); } else if ((tt) + 2 < NT) { WAIT_BAR(1); } else { WAIT_BAR(0); } } while (0)
  for (; t + 1 < NT; t += 2) {
    STEP(pB0, pB1, pA0, pA1, t, (t + 3 < NT), (t + 1 < NT), (t + 1 < NT));         ENDW(t);     RESC(); ROT();
    STEP(pA0, pA1, pB0, pB1, t + 1, (t + 4 < NT), (t + 2 < NT), (t + 2 < NT));     ENDW(t + 1); RESC(); ROT();
  }
  STEP(pB0, pB1, pA0, pA1, NT - 1, false, false, false); RESC();
  { float sacc = pB0[0] + pB0[1];
#pragma unroll
    for (int r = 2; r < 16; ++r) sacc += pB0[r];
#pragma unroll
    for (int r = 0; r < 16; ++r) sacc += pB1[r];
    l_reg += sacc;
    pw0 = (u32x4){PKW(pB0, 0), PKW(pB0, 2), PKW(pB0, 4), PKW(pB0, 6)}; pw1 = (u32x4){PKW(pB0, 8), PKW(pB0, 10), PKW(pB0, 12), PKW(pB0, 14)};
    pw2 = (u32x4){PKW(pB1, 0), PKW(pB1, 2), PKW(pB1, 4), PKW(pB1, 6)}; pw3 = (u32x4){PKW(pB1, 8), PKW(pB1, 10), PKW(pB1, 12), PKW(pB1, 14)};
    const lds_cptr vp_ = vp0 + sl_cur;
#pragma unroll
    for (int i = 0; i < 8; ++i) VRD(i);
    o[0] = MFMA(VFR(0), PAF(0), o[0]); o[1] = MFMA(VFR(4), PAF(0), o[1]); o[0] = MFMA(VFR(1), PAF(1), o[0]); o[1] = MFMA(VFR(5), PAF(1), o[1]);
    o[0] = MFMA(VFR(2), PAF(2), o[0]); o[1] = MFMA(VFR(6), PAF(2), o[1]); o[0] = MFMA(VFR(3), PAF(3), o[0]); o[1] = MFMA(VFR(7), PAF(3), o[1]); }
  { auto rr = __builtin_amdgcn_permlane32_swap(__float_as_uint(l_reg), __float_as_uint(l_reg), false, false); l_reg = __uint_as_float(rr[0]) + __uint_as_float(rr[1]); }
  const float rl = __builtin_amdgcn_rcpf(l_reg);
  bf16_t* Ow = Ob + (long)(wid * QBLK + r32) * LDO + 4 * hi;
#pragma unroll
  for (int d0 = 0; d0 < 2; ++d0)
#pragma unroll
    for (int i = 0; i < 4; ++i) { u32x2 w; w.x = pk2(o[d0][4 * i] * rl, o[d0][4 * i + 1] * rl); w.y = pk2(o[d0][4 * i + 2] * rl, o[d0][4 * i + 3] * rl); *(u32x2*)(Ow + d0 * 32 + 8 * i) = w; }
  asm volatile("s_waitcnt lgkmcnt(0)\n\ts_barrier" ::: "memory");
#undef DMA_K
#undef DMA_V
#undef WAITB
#undef RESC
#undef ROT
#undef PKW
#undef PAF
#undef VFR
#undef PIN
#undef EX
#undef VRD
#undef KRD
#undef GA3
#undef GA2
#undef GA2S
#undef GAPB
#undef STEP
#undef ENDW
}
#undef SBAR
#undef WAIT_BAR
#undef MX3
#undef MFMA
}

struct Ptrs {
    const float* x; const int* pos; const float *g_mix, *w_in, *g_q, *w_uq, *g_kv, *w_ukv, *conv_w, *conv_b, *ig_b, *fg_b, *g_on, *w_bm, *w_bl, *w_out, *g_mlp, *w_up, *w_dn, *g_fin;
    float* out; unsigned char* ws;
    bf16_t *WinT, *WuqT, *WukvT, *WbmT, *WblT, *WoutT, *WupT, *WdnT;
    float *ROPE, *SSQ, *SSQ1, *SSQ2, *G32, *UN, *BL, *ML, *MP;
    bf16_t *H0, *HQK, *HVO, *HG, *XN, *UC, *QC, *KC, *VTG, *G1, *MERGED, *X1B, *ACT, *YA, *YM, *Q, *KV, *KR;
};

__device__ __forceinline__ float logsig_(float x) { return fminf(x, 0.f) - log1pf(__expf(-fabsf(x))); }
__device__ __forceinline__ float wave_scan_add(float v, int lane) {
#pragma unroll
    for (int o = 1; o < 64; o <<= 1) { const float t = __shfl_up(v, o); if (lane >= o) v += t; }
    return v;
}
__device__ __forceinline__ float wave_scan_max(float v, int lane) {
#pragma unroll
    for (int o = 1; o < 64; o <<= 1) { const float t = __shfl_up(v, o); if (lane >= o) v = fmaxf(v, t); }
    return v;
}
__device__ __forceinline__ float wave_max(float v) {
#pragma unroll
    for (int o = 1; o < 64; o <<= 1) v = fmaxf(v, __shfl_xor(v, o));
    return v;
}
__device__ __forceinline__ f32x4 mfma16(bf16x8 a, bf16x8 b, f32x4 c) { return __builtin_amdgcn_mfma_f32_16x16x32_bf16(a, b, c, 0, 0, 0); }
__device__ __forceinline__ void conv_load(const bf16_t* __restrict__ HQK, long trow0, long seq_lo, long seq_hi, int ch, int tg, u32x4 (&xr)[6]) {
#pragma unroll
    for (int i = 0; i < 6; ++i) { const long r = trow0 + 2 * tg - 2 + i;
        const bool in = (r >= seq_lo && r < seq_hi); const long rc = in ? r : seq_lo; const u32x4 w = *(const u32x4*)(HQK + rc * 1024 + ch); const unsigned mk = in ? 0xffffffffu : 0u;
        xr[i] = (u32x4){w.x & mk, w.y & mk, w.z & mk, w.w & mk}; }
}
__device__ __forceinline__ void conv_compute(const u32x4 (&xr)[6], int ch, const float* __restrict__ cw, const float* __restrict__ cbias, float (&o0)[8], float (&o1)[8]) {
    asm volatile("" : "+v"(ch));
    const f32x4 b0 = *(const f32x4*)(cbias + ch), b1 = *(const f32x4*)(cbias + ch + 4);
#pragma unroll
    for (int e = 0; e < 8; ++e) { o0[e] = e < 4 ? b0[e & 3] : b1[e & 3]; o1[e] = o0[e]; }
#define XV(i, e) (((e) & 1) ? bfhi(xr[i][(e) >> 1]) : bflo(xr[i][(e) >> 1]))
#pragma unroll
    for (int j = 0; j < 5; ++j) { const f32x4 w0 = *(const f32x4*)(cw + j * 1024 + ch), w1 = *(const f32x4*)(cw + j * 1024 + ch + 4);
#pragma unroll
        for (int e = 0; e < 8; ++e) { const float w = e < 4 ? w0[e & 3] : w1[e & 3]; o0[e] += w * XV(j, e); o1[e] += w * XV(j + 1, e); } }
#undef XV
#pragma unroll
    for (int e = 0; e < 8; ++e) { o0[e] = o0[e] * sigmoidf_(o0[e]); o1[e] = o1[e] * sigmoidf_(o1[e]); }
}
__device__ __forceinline__ void vt_load(const bf16_t* __restrict__ HVO, long t0, int h, int tid, u32x4 (&w)[2]) {
    const int cc = (tid & 3) | (((tid >> 7) & 3) << 2), s = (tid >> 2) & 31;
#pragma unroll
    for (int half = 0; half < 2; ++half) w[half] = *(const u32x4*)(HVO + (t0 + s + 32 * half) * 1024 + h * 128 + 8 * cc);
}
__device__ __forceinline__ void vt_scatter(const u32x4 (&wv)[2], LAS bf16_t* VT, int tid) {
    const int cc = (tid & 3) | (((tid >> 7) & 3) << 2), s = (tid >> 2) & 31;
#pragma unroll
    for (int half = 0; half < 2; ++half) { const int ss = s + 32 * half; const u32x4 w = wv[half];
        LAS bf16_t* p = VT + (8 * cc) * 72 + ss;
        p[0 * 72] = (bf16_t)(w.x & 0xffffu); p[1 * 72] = (bf16_t)(w.x >> 16); p[2 * 72] = (bf16_t)(w.y & 0xffffu); p[3 * 72] = (bf16_t)(w.y >> 16);
        p[4 * 72] = (bf16_t)(w.z & 0xffffu); p[5 * 72] = (bf16_t)(w.z >> 16); p[6 * 72] = (bf16_t)(w.w & 0xffffu); p[7 * 72] = (bf16_t)(w.w >> 16); }
}
constexpr float KSCALE = 0.08838834764831845f;

constexpr int NCH = 32;
__device__ __forceinline__ f32x16 mfma32(bf16x8 a, bf16x8 b, f32x16 c) { return __builtin_amdgcn_mfma_f32_32x32x16_bf16(a, b, c, 0, 0, 0); }
__device__ __forceinline__ void mlstm_pass1_unit(const Ptrs& P, LAS unsigned char* lds, int b, int h, int c, int tid) {
    asm volatile("" : "+v"(tid));
    const int lane = tid & 63, wid = __builtin_amdgcn_readfirstlane(tid >> 6);
    LAS float* W = (LAS float*)lds;
    LAS float* SC = (LAS float*)(lds + 2048);
    LAS bf16_t* KTW = (LAS bf16_t*)(lds + 4096);
    LAS bf16_t* VT = (LAS bf16_t*)(lds + 4096 + 36864);
    const long t0 = (long)b * SEQ + 256 * c;
    { const int dir = tid >> 8, j = tid & 255, o = dir ? 255 - j : j; const long t = t0 + o; const int base = wid & 4, w4 = wid & 3;
      const float f = P.G32[t * 16 + dir * 8 + 4 + h] + P.fg_b[dir * 4 + h], ig = P.G32[t * 16 + dir * 8 + h] + P.ig_b[dir * 4 + h];
      const float incl = wave_scan_add(logsig_(f), lane); if (lane == 63) SC[wid] = incl;
      __syncthreads();
      const float off = (w4 > 0 ? SC[base] : 0.f) + (w4 > 1 ? SC[base + 1] : 0.f) + (w4 > 2 ? SC[base + 2] : 0.f);
      const float bl = (SC[base] + SC[base + 1]) + (SC[base + 2] + SC[base + 3]);
      const float we = bl - (incl + off) + ig, wm = wave_max(we); if (lane == 0) SC[8 + wid] = wm;
      __syncthreads();
      const float mloc = fmaxf(fmaxf(SC[8 + base], SC[8 + base + 1]), fmaxf(SC[8 + base + 2], SC[8 + base + 3]));
      W[dir * 256 + o] = __expf(we - mloc);
      if (j == 0) { const int chain = (dir * 2 + b) * 4 + h, cd = dir ? NCH - 1 - c : c; P.BL[chain * NCH + cd] = bl; P.ML[chain * NCH + cd] = mloc; }
    }
    __syncthreads();
    const int dirw = wid >> 2, mb = wid & 3, l15 = lane & 15, lq = lane >> 4;
    f32x4 acc[2][8];
#pragma unroll
    for (int mt = 0; mt < 2; ++mt)
#pragma unroll
        for (int nt = 0; nt < 8; ++nt) acc[mt][nt] = (f32x4){0.f, 0.f, 0.f, 0.f};
    float unacc = 0.f;
#pragma unroll 1
    for (int sub = 0; sub < 4; ++sub) {
        const long ts = t0 + 64 * sub;
        int tl = tid; asm volatile("" : "+v"(tl));
        const int ll15 = tl & 15, llq = (tl & 63) >> 4;
        { const int tg = (tl >> 2) & 31, cc = (tl & 3) | (((tl >> 7) & 3) << 2); float k0[8], k1[8];
          u32x4 xq[6], xk[6], wv[2];
          conv_load(P.HQK, ts, (long)b * SEQ, (long)(b + 1) * SEQ, h * 128 + 8 * cc, tg, xq);
          conv_compute(xq, h * 128 + 8 * cc, P.conv_w, P.conv_b, k0, k1);
          { u32x4 w0, w1; w0.x = pk2(k0[0], k0[1]); w0.y = pk2(k0[2], k0[3]); w0.z = pk2(k0[4], k0[5]); w0.w = pk2(k0[6], k0[7]);
            w1.x = pk2(k1[0], k1[1]); w1.y = pk2(k1[2], k1[3]); w1.z = pk2(k1[4], k1[5]); w1.w = pk2(k1[6], k1[7]);
            *(u32x4*)(P.QC + (ts + 2 * tg) * 512 + h * 128 + 8 * cc) = w0; *(u32x4*)(P.QC + (ts + 2 * tg + 1) * 512 + h * 128 + 8 * cc) = w1; }
          asm volatile("" ::: "memory");
          conv_load(P.HQK, ts, (long)b * SEQ, (long)(b + 1) * SEQ, 512 + h * 128 + 8 * cc, tg, xk);
          vt_load(P.HVO, ts, h, tl, wv);
          conv_compute(xk, 512 + h * 128 + 8 * cc, P.conv_w, P.conv_b, k0, k1);
#pragma unroll
          for (int e = 0; e < 8; ++e) { k0[e] *= KSCALE; k1[e] *= KSCALE; }
          { u32x4 w0, w1; w0.x = pk2(k0[0], k0[1]); w0.y = pk2(k0[2], k0[3]); w0.z = pk2(k0[4], k0[5]); w0.w = pk2(k0[6], k0[7]);
            w1.x = pk2(k1[0], k1[1]); w1.y = pk2(k1[2], k1[3]); w1.z = pk2(k1[4], k1[5]); w1.w = pk2(k1[6], k1[7]);
            *(u32x4*)(P.KC + (ts + 2 * tg) * 512 + h * 128 + 8 * cc) = w0; *(u32x4*)(P.KC + (ts + 2 * tg + 1) * 512 + h * 128 + 8 * cc) = w1; }
          const int ow = 64 * sub + 2 * tg;
          const float wf0 = W[ow], wf1 = W[ow + 1], wb0 = W[256 + ow], wb1 = W[256 + ow + 1];
#pragma unroll
          for (int e = 0; e < 8; ++e) { const int dk = 8 * cc + e;
              *(LAS unsigned*)(KTW + dk * 72 + 2 * tg) = pk2(wf0 * k0[e], wf1 * k1[e]);
              *(LAS unsigned*)(KTW + (128 + dk) * 72 + 2 * tg) = pk2(wb0 * k0[e], wb1 * k1[e]); }
          vt_scatter(wv, VT, tl); }
        __syncthreads();
        { bf16x8 X[2][2];
#pragma unroll
          for (int mt = 0; mt < 2; ++mt)
#pragma unroll
              for (int ks = 0; ks < 2; ++ks) X[mt][ks] = *(const LAS bf16x8*)(KTW + (dirw * 128 + mb * 32 + mt * 16 + ll15) * 72 + ks * 32 + llq * 8);
#pragma unroll
          for (int nt = 0; nt < 8; ++nt)
#pragma unroll
              for (int ks = 0; ks < 2; ++ks) { const bf16x8 Y = *(const LAS bf16x8*)(VT + (nt * 16 + ll15) * 72 + ks * 32 + llq * 8);
#pragma unroll
                  for (int mt = 0; mt < 2; ++mt) acc[mt][nt] = mfma16(X[mt][ks], Y, acc[mt][nt]); } }
        { const int d2 = tl >> 8, dk = (tl >> 1) & 127, hf = tl & 1;
#pragma unroll 8
          for (int i = 0; i < 32; ++i) unacc += bf2f(KTW[(d2 * 128 + dk) * 72 + hf * 32 + i]); }
#pragma unroll
        for (int i = 0; i < 2; ++i) { const int idx = tl + 512 * i, dv = idx >> 3, ch = idx & 7;
            *(u32x4*)(P.VTG + ((size_t)((b * 4 + h) * 128 + dv)) * SEQ + 256 * c + 64 * sub + 8 * ch) = *(const LAS u32x4*)(VT + dv * 72 + 8 * ch); }
        __syncthreads();
    }
    { const int chain = (dirw * 2 + b) * 4 + h, cd = dirw ? NCH - 1 - c : c;
      bf16_t* Ub = P.UC + (size_t)(chain * NCH + cd) * 16384;
#pragma unroll
      for (int mt = 0; mt < 2; ++mt)
#pragma unroll
          for (int nt = 0; nt < 8; ++nt) { const int dv = nt * 16 + l15, dk = mb * 32 + mt * 16 + 4 * lq; u32x2 w; w.x = pk2(acc[mt][nt][0], acc[mt][nt][1]); w.y = pk2(acc[mt][nt][2], acc[mt][nt][3]);
              *(u32x2*)(Ub + dv * 128 + dk) = w; } }
    { const int d2 = tid >> 8, dk = (tid >> 1) & 127, hf = tid & 1;
      unacc += __shfl_xor(unacc, 1);
      const int chain = (d2 * 2 + b) * 4 + h, cd = d2 ? NCH - 1 - c : c;
      if (hf == 0) P.UN[(size_t)(chain * NCH + cd) * 128 + dk] = unacc; }
    __syncthreads();
}
__device__ __forceinline__ void mlstm_pass2(const Ptrs& P, LAS unsigned char* lds, int vcu, int G, int tid) {
    LAS float* DEC = (LAS float*)lds; LAS float* BET = DEC + 512; LAS float* LBL = DEC + 1024; LAS float* LML = DEC + 1536;
    if (G == 256) {
        const int x = vcu >> 5, r = vcu & 31, bb = x >> 2, hh = x & 3;
        if (tid < 2 * NCH) { const int chain = ((tid >> 5) * 2 + bb) * 4 + hh; LBL[tid] = P.BL[chain * NCH + (tid & 31)]; LML[tid] = P.ML[chain * NCH + (tid & 31)]; }
        __syncthreads();
        if (tid < 2) { const int chain = (tid * 2 + bb) * 4 + hh; float m = 0.f;
            for (int c = 0; c < NCH; ++c) { const float bl = LBL[tid * NCH + c], ml = LML[tid * NCH + c]; if (r == 0) P.MP[chain * NCH + c] = m;
                const float mn = fmaxf(bl + m, ml); DEC[tid * NCH + c] = __expf(bl + m - mn); BET[tid * NCH + c] = __expf(ml - mn); m = mn; } }
        __syncthreads();
        { const int li = r * 512 + tid, dir = li >> 13, e2 = li & 8191, chain = (dir * 2 + bb) * 4 + hh;
          unsigned* p = (unsigned*)P.UC + (size_t)chain * NCH * 8192 + e2; float s0 = 0.f, s1 = 0.f;
          for (int c0 = 0; c0 < NCH; c0 += 8) { unsigned u[8];
#pragma unroll
              for (int k = 0; k < 8; ++k) u[k] = p[(size_t)(c0 + k) * 8192];
#pragma unroll
              for (int k = 0; k < 8; ++k) { const float d = DEC[dir * NCH + c0 + k], bt = BET[dir * NCH + c0 + k]; p[(size_t)(c0 + k) * 8192] = pk2(s0, s1);
                  s0 = d * s0 + bt * bflo(u[k]); s1 = d * s1 + bt * bfhi(u[k]); } } }
        if (r == 0 && tid < 256) { const int dir = tid >> 7, dk = tid & 127, chain = (dir * 2 + bb) * 4 + hh; float* p = P.UN + (size_t)chain * NCH * 128 + dk; float s = 0.f;
            for (int c = 0; c < NCH; ++c) { const float u = p[c * 128]; p[c * 128] = s; s = DEC[dir * NCH + c] * s + BET[dir * NCH + c] * u; } }
        __syncthreads();
        return;
    }
    if (tid < 16 * NCH) { LBL[tid] = P.BL[tid]; LML[tid] = P.ML[tid]; }
    __syncthreads();
    if (tid < 16) { const int chain = tid; float m = 0.f;
        for (int c = 0; c < NCH; ++c) { const float bl = LBL[chain * NCH + c], ml = LML[chain * NCH + c]; if (vcu == 0) P.MP[chain * NCH + c] = m;
            const float mn = fmaxf(bl + m, ml); DEC[chain * NCH + c] = __expf(bl + m - mn); BET[chain * NCH + c] = __expf(ml - mn); m = mn; } }
    __syncthreads();
    unsigned* UCw = (unsigned*)P.UC;
    for (int w = vcu * 512 + tid; w < 16 * 8192; w += G * 512) { const int chain = w >> 13, e2 = w & 8191; unsigned* p = UCw + (size_t)chain * NCH * 8192 + e2; float s0 = 0.f, s1 = 0.f;
        for (int c0 = 0; c0 < NCH; c0 += 8) { unsigned u[8];
#pragma unroll
            for (int k = 0; k < 8; ++k) u[k] = p[(size_t)(c0 + k) * 8192];
#pragma unroll
            for (int k = 0; k < 8; ++k) { const float d = DEC[chain * NCH + c0 + k], bt = BET[chain * NCH + c0 + k]; p[(size_t)(c0 + k) * 8192] = pk2(s0, s1);
                s0 = d * s0 + bt * bflo(u[k]); s1 = d * s1 + bt * bfhi(u[k]); } } }
    for (int w = vcu * 512 + tid; w < 2048; w += G * 512) { const int chain = w >> 7, dk = w & 127; float* p = P.UN + (size_t)chain * NCH * 128 + dk; float s = 0.f;
        for (int c = 0; c < NCH; ++c) { const float u = p[c * 128]; p[c * 128] = s; s = DEC[chain * NCH + c] * s + BET[chain * NCH + c] * u; } }
    __syncthreads();
}
__device__ __forceinline__ void mlstm_pass3_unit(const Ptrs& P, LAS unsigned char* lds, int b, int h, int c, int tid) {
    asm volatile("" : "+v"(tid));
    const int lane = tid & 63, wid = __builtin_amdgcn_readfirstlane(tid >> 6), l31 = lane & 31, hi = lane >> 5;
    LAS bf16_t* KS = (LAS bf16_t*)lds;
    LAS bf16_t* VT = (LAS bf16_t*)(lds + 69632);
    LAS float* PA = (LAS float*)(lds + 137216);
    LAS float* PMU = PA + 512; LAS float* PIW = PA + 1024; LAS float* PFL = PA + 1536; LAS float* SC = PA + 2048;
    const long t0 = (long)b * SEQ + 256 * c;
    u32x4 stg[16];
#pragma unroll
    for (int i = 0; i < 8; ++i) { const int idx = tid + 512 * i, row = idx >> 4, ch = idx & 15; stg[i] = *(const u32x4*)(P.KC + (t0 + row) * 512 + h * 128 + 8 * ch); }
#pragma unroll
    for (int i = 0; i < 8; ++i) { const int idx = tid + 512 * i, dv = idx >> 5, ch = idx & 31; stg[8 + i] = *(const u32x4*)(P.VTG + ((size_t)((b * 4 + h) * 128 + dv)) * SEQ + 256 * c + 8 * ch); }
    const int o1 = 32 * wid + l31;
    bf16x8 qf[8];
    { const bf16_t* qp = P.QC + (t0 + o1) * 512 + h * 128 + 8 * hi;
#pragma unroll
      for (int s = 0; s < 8; ++s) qf[s] = *(const bf16x8*)(qp + 16 * s); }
    { const int dir = tid >> 8, j = tid & 255, o = dir ? 255 - j : j; const long t = t0 + o; const int base = wid & 4, w4 = wid & 3;
      const int chain = (dir * 2 + b) * 4 + h, cd = dir ? NCH - 1 - c : c;
      const float f = P.G32[t * 16 + dir * 8 + 4 + h] + P.fg_b[dir * 4 + h], ig = P.G32[t * 16 + dir * 8 + h] + P.ig_b[dir * 4 + h];
      const float incl = wave_scan_add(logsig_(f), lane); if (lane == 63) SC[wid] = incl;
      __syncthreads();
      const float off = (w4 > 0 ? SC[base] : 0.f) + (w4 > 1 ? SC[base + 1] : 0.f) + (w4 > 2 ? SC[base + 2] : 0.f);
      const float bs = incl + off, a = ig - bs, imax = wave_scan_max(a, lane); if (lane == 63) SC[8 + wid] = imax;
      __syncthreads();
      float pm = -__builtin_inff(); if (w4 > 0) pm = SC[8 + base]; if (w4 > 1) pm = fmaxf(pm, SC[8 + base + 1]); if (w4 > 2) pm = fmaxf(pm, SC[8 + base + 2]);
      const float mp = P.MP[chain * NCH + cd], mu = fmaxf(mp, fmaxf(imax, pm));
      PA[dir * 256 + o] = a; PMU[dir * 256 + o] = mu; PIW[dir * 256 + o] = __expf(mp - mu); PFL[dir * 256 + o] = __expf(-(bs + mu)); }
#pragma unroll
    for (int i = 0; i < 8; ++i) { const int idx = tid + 512 * i, row = idx >> 4, ch = idx & 15; *(LAS u32x4*)(KS + row * 136 + 8 * ch) = stg[i]; }
#pragma unroll
    for (int i = 0; i < 8; ++i) { const int idx = tid + 512 * i, dv = idx >> 5, ch = idx & 31; *(LAS u32x4*)(VT + dv * 264 + 8 * ch) = stg[8 + i]; }
    __syncthreads();
    f32x16 hs[4];
#pragma unroll
    for (int dir = 0; dir < 2; ++dir) {
        const int chain = (dir * 2 + b) * 4 + h, cd = dir ? NCH - 1 - c : c;
        const float mu1 = PMU[dir * 256 + o1], iw1 = PIW[dir * 256 + o1], fl1 = PFL[dir * 256 + o1];
        f32x16 acc[4];
#define CLD4(dst, D, S0) do { int ll_ = lane; asm volatile("" : "+v"(ll_)); const bf16_t* cp_ = P.UC + (size_t)(chain * NCH + cd) * 16384 + (32 * (D) + (ll_ & 31)) * 128 + 8 * (ll_ >> 5) + 16 * (S0); \
            _Pragma("unroll") for (int s_ = 0; s_ < 4; ++s_) dst[s_] = *(const bf16x8*)(cp_ + 16 * s_); } while (0)
#define MM4(D, src, S0) do { _Pragma("unroll") for (int s_ = 0; s_ < 4; ++s_) acc[D] = mfma32(src[s_], qf[(S0) + s_], acc[D]); } while (0)
        if (dir == 0) {
            bf16x8 ca[4], cb[4], cc[4];
            CLD4(ca, 0, 0); CLD4(cb, 0, 4);
#pragma unroll
            for (int d = 0; d < 4; ++d) { acc[d] = f32x16{};
                if (d < 3) CLD4(cc, d + 1, 0);
                __builtin_amdgcn_sched_barrier(0); MM4(d, ca, 0); __builtin_amdgcn_sched_barrier(0);
                if (d < 3) CLD4(ca, d + 1, 4);
                __builtin_amdgcn_sched_barrier(0); MM4(d, cb, 4); acc[d] *= iw1; __builtin_amdgcn_sched_barrier(0);
                if (d < 3) {
#pragma unroll
                    for (int s_ = 0; s_ < 4; ++s_) { const bf16x8 t_ = ca[s_]; ca[s_] = cc[s_]; cb[s_] = t_; } } }
        } else {
#pragma unroll
            for (int d = 0; d < 4; ++d) { acc[d] = f32x16{}; bf16x8 ca[4], cb[4]; CLD4(ca, d, 0); CLD4(cb, d, 4);
                MM4(d, ca, 0); MM4(d, cb, 4); acc[d] *= iw1; asm volatile("" ::: "memory"); __builtin_amdgcn_sched_barrier(0); }
        }
#undef CLD4
#undef MM4
        float qn = 0.f;
        { const float* np = P.UN + (size_t)(chain * NCH + cd) * 128 + 8 * hi;
#pragma unroll
          for (int s = 0; s < 8; ++s) { const f32x4 n0 = *(const f32x4*)(np + 16 * s), n1 = *(const f32x4*)(np + 16 * s + 4); const u32x4 w = __builtin_bit_cast(u32x4, qf[s]);
              qn += bflo(w.x) * n0[0] + bfhi(w.x) * n0[1] + bflo(w.y) * n0[2] + bfhi(w.y) * n0[3] + bflo(w.z) * n1[0] + bfhi(w.z) * n1[1] + bflo(w.w) * n1[2] + bfhi(w.w) * n1[3]; }
          qn += __shfl_xor(qn, 32); }
        float dsum = 0.f;
        const int kb_lo = dir ? wid : 0, kb_hi = dir ? 7 : wid;
#pragma unroll 1
        for (int kb = kb_lo; kb <= kb_hi; ++kb) {
            int ll = lane; asm volatile("" : "+v"(ll));
            const int l31 = ll & 31, hi = ll >> 5;
            f32x16 S = f32x16{};
#pragma unroll
            for (int s = 0; s < 8; ++s) { const bf16x8 A = *(const LAS bf16x8*)(KS + (32 * kb + l31) * 136 + 16 * s + 8 * hi); S = mfma32(A, qf[s], S); if ((s & 3) == 3) __builtin_amdgcn_sched_barrier(0); }
            const bool diag = (kb == wid);
#pragma unroll
            for (int i = 0; i < 4; ++i) { const f32x4 a4 = *(const LAS f32x4*)(PA + dir * 256 + 32 * kb + 8 * i + 4 * hi);
#pragma unroll
                for (int e = 0; e < 4; ++e) { const int key = 32 * kb + 8 * i + 4 * hi + e; const bool ok = !diag || (dir ? (key >= o1) : (key <= o1));
                    const float p = ok ? S[4 * i + e] * __expf(fminf(a4[e] - mu1, 0.f)) : 0.f; dsum += p; S[4 * i + e] = p; } }
            u32x4 w0, w1; w0.x = pk2(S[0], S[1]); w0.y = pk2(S[2], S[3]); w0.z = pk2(S[4], S[5]); w0.w = pk2(S[6], S[7]);
            w1.x = pk2(S[8], S[9]); w1.y = pk2(S[10], S[11]); w1.z = pk2(S[12], S[13]); w1.w = pk2(S[14], S[15]);
            const bf16x8 pf0 = __builtin_bit_cast(bf16x8, w0), pf1 = __builtin_bit_cast(bf16x8, w1);
#pragma unroll
            for (int d = 0; d < 4; ++d) { const LAS bf16_t* vp = VT + (32 * d + l31) * 264 + 32 * kb + 4 * hi;
                u32x4 A0, A1; { const u32x2 lo = *(const LAS u32x2*)vp, hh = *(const LAS u32x2*)(vp + 8); A0 = (u32x4){lo.x, lo.y, hh.x, hh.y}; }
                { const u32x2 lo = *(const LAS u32x2*)(vp + 16), hh = *(const LAS u32x2*)(vp + 24); A1 = (u32x4){lo.x, lo.y, hh.x, hh.y}; }
                acc[d] = mfma32(__builtin_bit_cast(bf16x8, A0), pf0, acc[d]); acc[d] = mfma32(__builtin_bit_cast(bf16x8, A1), pf1, acc[d]); __builtin_amdgcn_sched_barrier(0); }
        }
        dsum += __shfl_xor(dsum, 32);
        const float den = iw1 * qn + dsum, dinv = 1.f / fmaxf(fabsf(den), fl1);
#pragma unroll
        for (int d = 0; d < 4; ++d) { if (dir == 0) hs[d] = acc[d] * dinv; else hs[d] += acc[d] * dinv; }
    }
    float ss = 0.f;
#pragma unroll
    for (int d = 0; d < 4; ++d)
#pragma unroll
        for (int r = 0; r < 16; ++r) ss += hs[d][r] * hs[d][r];
    ss += __shfl_xor(ss, 32);
    const float rn = rsqrtf(ss * (1.f / 128.f) + NORM_EPS);
#pragma unroll
    for (int dd = 0; dd < 2; ++dd) {
        int ll = lane; asm volatile("" : "+v"(ll)); const int hi = ll >> 5, o1 = 32 * wid + (ll & 31);
        u32x2 mo[8]; f32x4 g4[8];
        { const bf16_t* mp_ = P.HVO + (t0 + o1) * 1024 + 512 + h * 128 + 64 * dd + 4 * hi;
#pragma unroll
          for (int j = 0; j < 8; ++j) mo[j] = *(const u32x2*)(mp_ + 8 * j); }
#pragma unroll
        for (int j = 0; j < 8; ++j) g4[j] = *(const f32x4*)(P.g_on + h * 128 + 64 * dd + 8 * j + 4 * hi);
#pragma unroll
        for (int j = 0; j < 8; ++j) { const int d = 2 * dd + (j >> 2), i = j & 3; const u32x2 m = mo[j]; bf16_t* mp = P.YM + (t0 + o1) * 1024 + h * 128 + 64 * dd + 8 * j + 4 * hi;
            u32x2 w; w.x = pk2(hs[d][4 * i] * rn * g4[j][0] * sigmoidf_(bflo(m.x)), hs[d][4 * i + 1] * rn * g4[j][1] * sigmoidf_(bfhi(m.x)));
            w.y = pk2(hs[d][4 * i + 2] * rn * g4[j][2] * sigmoidf_(bflo(m.y)), hs[d][4 * i + 3] * rn * g4[j][3] * sigmoidf_(bfhi(m.y)));
            *(u32x2*)mp = w; }
        asm volatile("" ::: "memory"); __builtin_amdgcn_sched_barrier(0); }
    __syncthreads();
}

#define XB_TMO      128
#define XB_MISMATCH 192
#define XB_XCNT(j)  (256  + 64 * (j))
#define XB_XSUB(j)  (1280 + 64 * (j))
#define XB_XGEN(j)  (2304 + 64 * (j))
#define XB_TOP      3328
#define XB_TOPGEN   3392
#define XCD_BAR_WORDS 3456
#define XB_SPIN_CAP (1u << 18)
__device__ __forceinline__ unsigned xb_ld(unsigned* p)              { return __hip_atomic_load(p, __ATOMIC_RELAXED, __HIP_MEMORY_SCOPE_AGENT); }
__device__ __forceinline__ unsigned xb_add(unsigned* p, unsigned v) { return __hip_atomic_fetch_add(p, v, __ATOMIC_RELAXED, __HIP_MEMORY_SCOPE_AGENT); }
__device__ __forceinline__ unsigned xb_xcc_id() { return (unsigned)__builtin_amdgcn_s_getreg((3 << 11) | 20) & 0xFu; }
#define XB_SPIN(cond, bar) do { unsigned _sp = 0; while (cond) { __builtin_amdgcn_s_sleep(1); \
    if ((++_sp & 255u) == 0u) { if (xb_ld(&(bar)[XB_TMO])) break; if (_sp > XB_SPIN_CAP) { atomicAdd(&(bar)[XB_TMO], 1u); break; } } } } while (0)
struct XcdBarrier { unsigned* bar; unsigned x; volatile LAS unsigned* st; };
__device__ __forceinline__ XcdBarrier xcd_barrier_post(unsigned* bar, volatile LAS unsigned* st) {
    XcdBarrier b; b.bar = bar; b.x = xb_xcc_id(); b.st = st;
    if (threadIdx.x == 0) { if (b.x != (blockIdx.x & 7u)) (void)xb_add(&bar[XB_MISMATCH], 1u); (void)xb_add(&bar[XB_XCNT(b.x)], 1u); }
    return b;
}
__device__ __forceinline__ void xcd_barrier_complete(unsigned* bar, unsigned x, unsigned& nloc, unsigned& nx) {
    const unsigned G = gridDim.x * gridDim.y * gridDim.z;
    unsigned sum, cnt, mine, sp = 0u;
    for (;;) {
        sum = 0u; cnt = 0u; mine = 0u;
#pragma unroll
        for (unsigned j = 0; j < 16; ++j) { const unsigned c = xb_ld(&bar[XB_XCNT(j)]); sum += c; cnt += (c > 0u) ? 1u : 0u; mine = (j == x) ? c : mine; }
        if (sum == G) break;
        __builtin_amdgcn_s_sleep(1);
        if ((++sp & 255u) == 0u) { if (xb_ld(&bar[XB_TMO])) break; if (sp > XB_SPIN_CAP) { atomicAdd(&bar[XB_TMO], 1u); break; } }
    }
    nloc = mine > 0u ? mine : 1u; nx = cnt > 0u ? cnt : 1u;
}
__device__ __forceinline__ void xcd_barrier(const XcdBarrier& b) {
    asm volatile("s_waitcnt vmcnt(0)" ::: "memory");
    __syncthreads();
    if (threadIdx.x == 0) {
        unsigned* bar = b.bar;
        __builtin_amdgcn_s_waitcnt(0);
        unsigned nloc = b.st[0], nx = b.st[1];
        if (nloc == 0u) { xcd_barrier_complete(bar, b.x, nloc, nx); b.st[0] = nloc; b.st[1] = nx; }
        const unsigned old = xb_add(&bar[XB_XSUB(b.x)], 1u);
        const unsigned gen = old / nloc;
        if (old + 1u == (gen + 1u) * nloc) {
            __builtin_amdgcn_fence(__ATOMIC_RELEASE, "agent");
            asm volatile("s_waitcnt vmcnt(0)" ::: "memory");
            const unsigned og = xb_add(&bar[XB_TOP], 1u);
            const unsigned tg = og / nx;
            if (og + 1u == (tg + 1u) * nx) xb_add(&bar[XB_TOPGEN], 1u);
            else XB_SPIN(xb_ld(&bar[XB_TOPGEN]) == tg, bar);
            __builtin_amdgcn_fence(__ATOMIC_ACQUIRE, "agent");
            xb_add(&bar[XB_XGEN(b.x)], 1u);
            asm volatile("s_waitcnt vmcnt(0)" ::: "memory");
        } else {
            XB_SPIN(xb_ld(&bar[XB_XGEN(b.x)]) == gen, bar);
            __builtin_amdgcn_fence(__ATOMIC_ACQUIRE, "agent");
            asm volatile("s_waitcnt vmcnt(0)" ::: "memory");
        }
    }
    __syncthreads();
}

__device__ __forceinline__ void xcd_local_barrier(const XcdBarrier& b, bool acq = true) {
    asm volatile("s_waitcnt vmcnt(0)" ::: "memory");
    __syncthreads();
    if (threadIdx.x == 0) {
        unsigned* bar = b.bar;
        __builtin_amdgcn_s_waitcnt(0);
        const unsigned nloc = b.st[0];
        const unsigned old = xb_add(&bar[XB_XSUB(b.x)], 1u);
        const unsigned gen = old / nloc;
        if (old + 1u == (gen + 1u) * nloc) { xb_add(&bar[XB_XGEN(b.x)], 1u); }
        else { XB_SPIN(xb_ld(&bar[XB_XGEN(b.x)]) == gen, bar); }
        if (acq) { __builtin_amdgcn_fence(__ATOMIC_ACQUIRE, "agent"); asm volatile("s_waitcnt vmcnt(0)" ::: "memory"); }
    }
    __syncthreads();
}

__device__ __forceinline__ void xcd_local_barrier_post(const XcdBarrier& b, unsigned* gcnt, bool acq = true) {
    asm volatile("s_waitcnt vmcnt(0)" ::: "memory");
    __syncthreads();
    if (threadIdx.x == 0) {
        unsigned* bar = b.bar;
        __builtin_amdgcn_s_waitcnt(0);
        const unsigned nloc = b.st[0];
        const unsigned old = xb_add(&bar[XB_XSUB(b.x)], 1u);
        const unsigned gen = old / nloc;
        if (old + 1u == (gen + 1u) * nloc) {
            xb_add(&bar[XB_XGEN(b.x)], 1u);
            __builtin_amdgcn_fence(__ATOMIC_RELEASE, "agent"); asm volatile("s_waitcnt vmcnt(0)" ::: "memory");
            (void)xb_add(gcnt, 1u);
        } else { XB_SPIN(xb_ld(&bar[XB_XGEN(b.x)]) == gen, bar); }
        if (acq) { __builtin_amdgcn_fence(__ATOMIC_ACQUIRE, "agent"); asm volatile("s_waitcnt vmcnt(0)" ::: "memory"); }
    }
    __syncthreads();
}
__device__ __forceinline__ void count_wait(unsigned* cnt, unsigned target) {
    if (threadIdx.x == 0) { unsigned sp_ = 0; while (xb_ld(cnt) < target) { __builtin_amdgcn_s_sleep(2); if (++sp_ > (1u << 22)) break; }
        __builtin_amdgcn_fence(__ATOMIC_ACQUIRE, "agent"); asm volatile("s_waitcnt vmcnt(0)" ::: "memory"); }
    __syncthreads();
}

__device__ __forceinline__ float wave_sum(float v) {
#pragma unroll
    for (int o = 1; o < 64; o <<= 1) v += __shfl_xor(v, o);
    return v;
}
__device__ __forceinline__ int map_row(int mode, int n) {
    if (mode == 1) { if (n < 672) return n; if (n < 2720) return n + 96; if (n < 2736) return n - 2048; return n + 80; }
    if (mode == 2) { const int hh = n / 96, d = n % 96; if (d < 64) return n; const int r = d - 64;
        const int p = (r < 16) ? 8 * (r >> 2) + (r & 3) : 8 * ((r - 16) >> 2) + 4 + ((r - 16) & 3); return hh * 96 + 64 + p; }
    return n;
}
__device__ __forceinline__ void p0_transpose_item(const float* __restrict__ W, int K, int N, bf16_t* WT, int ldw, int mode, const float* __restrict__ gain, int item, int lane) {
    const int nblk = (N + 63) / 64, kb = item / nblk, nb = item % nblk, k0 = 32 * kb, n = 64 * nb + lane;
    if (n < N) {
        float v[32];
#pragma unroll
        for (int i = 0; i < 32; ++i) v[i] = __builtin_nontemporal_load(&W[(size_t)(k0 + i) * N + n]);
        if (gain) {
#pragma unroll
            for (int i = 0; i < 32; ++i) v[i] *= gain[k0 + i]; }
        bf16_t* dst = WT + (size_t)map_row(mode, n) * ldw + k0;
#pragma unroll
        for (int j = 0; j < 4; ++j) { u32x4 o; o.x = pk2(v[8 * j], v[8 * j + 1]); o.y = pk2(v[8 * j + 2], v[8 * j + 3]); o.z = pk2(v[8 * j + 4], v[8 * j + 5]); o.w = pk2(v[8 * j + 6], v[8 * j + 7]);
            *(u32x4*)(dst + 8 * j) = o; }
    }
}
__device__ __forceinline__ void sincos_acc(float ang, float& sn, float& cs) {
    const double x = (double)ang; const double kq = __builtin_rint(x * 0.63661977236758134308); const double r = x - kq * 1.57079632679489661923; const double r2 = r * r;
    const double s = r * (1.0 + r2 * (-1.0 / 6 + r2 * (1.0 / 120 + r2 * (-1.0 / 5040 + r2 * (1.0 / 362880 + r2 * (-1.0 / 39916800 + r2 * (1.0 / 6227020800.0)))))));
    const double c = 1.0 + r2 * (-0.5 + r2 * (1.0 / 24 + r2 * (-1.0 / 720 + r2 * (1.0 / 40320 + r2 * (-1.0 / 3628800 + r2 * (1.0 / 479001600.0 + r2 * (-1.0 / 87178291200.0)))))));
    const int q = ((int)kq) & 3;
    const double ss = (q == 0) ? s : (q == 1) ? c : (q == 2) ? -s : -c, cc = (q == 0) ? c : (q == 1) ? -s : (q == 2) ? -c : s;
    sn = (float)ss; cs = (float)cc;
}

constexpr int LDS_BYTES = 149504;
constexpr int MISC_OFF = LDS_BYTES - 128;
struct Args { const void* in[20]; float* out; unsigned char* ws; int ph_lo, ph_hi, li, pad; };

#define MKP() \
    Ptrs P; \
    P.x = (const float*)args.in[0]; P.pos = (const int*)args.in[1]; P.g_mix = (const float*)args.in[2]; P.w_in = (const float*)args.in[3]; P.g_q = (const float*)args.in[4]; \
    P.w_uq = (const float*)args.in[5]; P.g_kv = (const float*)args.in[6]; P.w_ukv = (const float*)args.in[7]; P.conv_w = (const float*)args.in[8]; P.conv_b = (const float*)args.in[9]; \
    P.ig_b = (const float*)args.in[10]; P.fg_b = (const float*)args.in[11]; P.g_on = (const float*)args.in[12]; P.w_bm = (const float*)args.in[13]; P.w_bl = (const float*)args.in[14]; \
    P.w_out = (const float*)args.in[15]; P.g_mlp = (const float*)args.in[16]; P.w_up = (const float*)args.in[17]; P.w_dn = (const float*)args.in[18]; P.g_fin = (const float*)args.in[19]; \
    P.out = args.out; P.ws = args.ws; \
    P.WinT = (bf16_t*)(ws + WS_WIN); P.WuqT = (bf16_t*)(ws + WS_WUQ); P.WukvT = (bf16_t*)(ws + WS_WUKV); P.WbmT = (bf16_t*)(ws + WS_WBM); P.WblT = (bf16_t*)(ws + WS_WBL); \
    P.WoutT = (bf16_t*)(ws + WS_WOUT); P.WupT = (bf16_t*)(ws + WS_WUP); P.WdnT = (bf16_t*)(ws + WS_WDN); \
    P.ROPE = (float*)(ws + WS_ROPE); P.SSQ = (float*)(ws + WS_SSQ); P.SSQ1 = (float*)(ws + WS_SSQ1); P.SSQ2 = (float*)(ws + WS_SSQ2); P.G32 = (float*)(ws + WS_G32); \
    P.UN = (float*)(ws + WS_UN); P.BL = (float*)(ws + WS_BL); P.ML = (float*)(ws + WS_ML); P.MP = (float*)(ws + WS_MP); \
    P.H0 = (bf16_t*)(ws + WS_H0); P.HQK = (bf16_t*)(ws + WS_HQK); P.HVO = (bf16_t*)(ws + WS_HVO); P.HG = (bf16_t*)(ws + WS_HG); \
    P.XN = (bf16_t*)(ws + WS_XN); P.UC = (bf16_t*)(ws + WS_UC); P.QC = (bf16_t*)(ws + WS_QC); P.KC = (bf16_t*)(ws + WS_KC); P.VTG = (bf16_t*)(ws + WS_VTG); P.G1 = (bf16_t*)(ws + WS_G1); P.MERGED = (bf16_t*)(ws + WS_MERGED); P.X1B = (bf16_t*)(ws + WS_X1B); \
    P.ACT = (bf16_t*)(ws + WS_ACT); P.YA = (bf16_t*)(ws + WS_YA); P.YM = (bf16_t*)(ws + WS_YM); \
    P.Q = (bf16_t*)((unsigned char*)args.out + DO_Q); P.KV = (bf16_t*)((unsigned char*)args.out + DO_KV); P.KR = (bf16_t*)((unsigned char*)args.out + DO_KR);

__global__ void __launch_bounds__(NWAVES * 64, 2) mk_fwd(Args args) {
    extern __shared__ __attribute__((aligned(16))) unsigned char lds_raw[];
    LAS unsigned char* lds = (LAS unsigned char*)lds_raw;
    const int tid = threadIdx.x, lane = tid & 63, wave = __builtin_amdgcn_readfirstlane(tid >> 6);
    const int G = gridDim.x; const int bx = blockIdx.x; const int vcu = (G % 8 == 0) ? (bx % 8) * (G / 8) + bx / 8 : bx;
    unsigned char* ws = args.ws;
    volatile LAS unsigned* MISC = (volatile LAS unsigned*)(lds + MISC_OFF);
    { int t0_ = tid; asm volatile("" : "+v"(t0_)); for (int u = t0_; u < (LDS_BYTES - 131072) / 4; u += NWAVES * 64) ((LAS unsigned*)(lds + 131072))[u] = 0u; }
    __syncthreads();
#if !MK_SPLIT
    XcdBarrier bar = xcd_barrier_post((unsigned*)(ws + WS_CTL) + CW_BAR, MISC + 8);
#define SEAM(k) do { if (IN((k) + 1)) xcd_barrier(bar); } while (0)
#define SEAML(k) do { if (IN((k) + 1)) { if (MISC[12]) xcd_local_barrier(bar, (k) == 7); else xcd_barrier(bar); } } while (0)
#else
#define SEAM(k) do { } while (0)
#define SEAML(k) do { } while (0)
#endif
    const int lo = args.ph_lo, hi = args.ph_hi;
#ifndef PH_MASK
#define PH_MASK 0x3ff
#endif
#define IN(k) (((PH_MASK >> (k)) & 1) && lo <= (k) && (k) < hi)
    const int gw = vcu * NWAVES + wave, NGW = G * NWAVES;

    if (IN(0)) { MKP();
#pragma unroll 1
      for (int rep = 0; rep < ((PROBE_DUP & 16) ? 2 : 1); ++rep) {
        constexpr int I_IN = (1024 / 32) * ((IN_COLS + 63) / 64), I_UQ = (384 / 32) * (768 / 64), I_UKV = (256 / 32) * (1024 / 64), I_BM = (512 / 32) * (1024 / 64), I_BL = I_BM,
                      I_OUT = (1024 / 32) * (1024 / 64), I_UP = (1024 / 32) * (4096 / 64), I_DN = (4096 / 32) * (1024 / 64);
        constexpr int NITEMS = I_IN + I_UQ + I_UKV + I_BM + I_BL + I_OUT + I_UP + I_DN;
        constexpr int NEARLY = I_IN + I_UQ + I_UKV;
#pragma unroll 1
      for (int stage = 0; stage < 2; ++stage) {
#pragma unroll 1
            for (int it = (stage ? NEARLY : 0) + gw; it < (stage ? NITEMS : NEARLY); it += NGW) {
                int r = it; const float* W; const float* gn = nullptr; bf16_t* WT; int K_, N_, mode = 0, ldw = 0;
                if (r < I_IN) { W = P.w_in; K_ = 1024; N_ = IN_COLS; WT = P.WinT; mode = 1; }
                else if ((r -= I_IN) < I_UQ) { W = P.w_uq; K_ = 384; N_ = 768; WT = P.WuqT; mode = 2; gn = P.g_q; }
                else if ((r -= I_UQ) < I_UKV) { W = P.w_ukv; K_ = 256; N_ = 1024; WT = P.WukvT; gn = P.g_kv; }
                else if ((r -= I_UKV) < I_BM) { W = P.w_bm; K_ = 512; N_ = 1024; WT = P.WbmT; ldw = 1024; }
                else if ((r -= I_BM) < I_BL) { W = P.w_bl; K_ = 512; N_ = 1024; WT = P.WbmT + 512; ldw = 1024; }
                else if ((r -= I_BL) < I_OUT) { W = P.w_out; K_ = 1024; N_ = 1024; WT = P.WoutT; }
                else if ((r -= I_OUT) < I_UP) { W = P.w_up; K_ = 1024; N_ = 4096; WT = P.WupT; gn = P.g_mlp; }
                else { r -= I_UP; W = P.w_dn; K_ = 4096; N_ = 1024; WT = P.WdnT; }
                p0_transpose_item(W, K_, N_, WT, ldw ? ldw : K_, mode, gn, r, lane);
            }
        if (stage == 0) {
        for (int i = vcu * 512 + tid; i < 80 * 1024 / 8; i += G * 512) *(u32x4*)(P.WinT + (size_t)688 * 1024 + (size_t)i * 8) = (u32x4){0u, 0u, 0u, 0u};
#pragma unroll 1
        for (int m = gw; m < M; m += 2 * NGW) {
            const int m2 = m + NGW;
            const f32x4* xa = (const f32x4*)(P.x + (size_t)m * 1024) + lane; const f32x4* xb = (const f32x4*)(P.x + (size_t)(m2 < M ? m2 : m) * 1024) + lane;
            f32x4 va[4], vb[4]; float sa = 0.f, sb = 0.f;
#pragma unroll
            for (int j = 0; j < 4; ++j) { va[j] = __builtin_nontemporal_load(&xa[64 * j]); vb[j] = __builtin_nontemporal_load(&xb[64 * j]); }
#pragma unroll
            for (int j = 0; j < 4; ++j) { sa += dot4(va[j]); sb += dot4(vb[j]); }
            const float ra = rsqrtf(wave_sum(sa) * (1.f / 1024.f) + NORM_EPS), rb = rsqrtf(wave_sum(sb) * (1.f / 1024.f) + NORM_EPS);
            u32x2* oa = (u32x2*)(P.XN + (size_t)m * 1024) + lane; u32x2* ob = (u32x2*)(P.XN + (size_t)m2 * 1024) + lane;
#pragma unroll
            for (int j = 0; j < 4; ++j) { const f32x4 g4 = *((const f32x4*)P.g_mix + lane + 64 * j); u32x2 w;
                w.x = pk2(va[j][0] * ra * g4[0], va[j][1] * ra * g4[1]); w.y = pk2(va[j][2] * ra * g4[2], va[j][3] * ra * g4[3]); st8wt(oa + 64 * j, w);
                if (m2 < M) { w.x = pk2(vb[j][0] * rb * g4[0], vb[j][1] * rb * g4[1]); w.y = pk2(vb[j][2] * rb * g4[2], vb[j][3] * rb * g4[3]); st8wt(ob + 64 * j, w); } }
        }
#if !MK_SPLIT
          if (tid == 0) { unsigned nloc_ = MISC[8], nx_ = MISC[9]; if (nloc_ == 0u) { xcd_barrier_complete((unsigned*)(ws + WS_CTL) + CW_BAR, bar.x, nloc_, nx_); MISC[8] = nloc_; MISC[9] = nx_; }
              MISC[12] = (G == 256 && xb_ld((unsigned*)(ws + WS_CTL) + CW_BAR + XB_MISMATCH) == 0u) ? 1u : 0u; }
          __syncthreads();
          if (MISC[12]) xcd_local_barrier_post(bar, (unsigned*)(ws + WS_CTL) + CW_G0, false);
#endif
        } else {
        const bool xl_ = !MK_SPLIT && MISC[12];
        for (int i = xl_ ? (vcu >> 5) * 32768 + (vcu & 31) * 512 + tid : vcu * 512 + tid; i < (xl_ ? ((vcu >> 5) + 1) * 32768 : M * 16); i += xl_ ? 16384 : G * 512) { const int m = i >> 4, j = i & 15;
            const float invf = (float)exp(-(double)j * (9.210340371976184 / 16.0));
            const float ang = (float)P.pos[m] * invf; float sn, cs; sincos_acc(ang, sn, cs);
            P.ROPE[(size_t)m * 32 + j] = cs; P.ROPE[(size_t)m * 32 + 16 + j] = sn; }
        }
      }
      }
#if !MK_SPLIT
        if (MISC[12]) { if (IN(1)) count_wait((unsigned*)(ws + WS_CTL) + CW_G0, MISC[9]); }
        else
#endif
        SEAM(0);
    }
    if (IN(1)) { MKP();
        pg8::Gemm g{P.XN, P.WinT, M, NIN, 1024, 1024, 1024}; pg8::StaticOrder S; S.init(M, NIN, G, bx);
        EpiIn E{P.H0, P.HQK, P.HVO, P.HG, P.SSQ, P.G32};
#pragma unroll 1
        for (int rep = 0; rep < ((PROBE_DUP & 4) ? 2 : 1); ++rep)
        pg8::gemm_phase<EpiIn, pg8::StaticOrder>(lds, g, S, E);
#if !MK_SPLIT
        if (MISC[12]) { if (IN(2)) xcd_local_barrier_post(bar, (unsigned*)(ws + WS_CTL) + CW_G1, false); }
        else
#endif
        SEAM(1);
    }
    if (IN(2)) { MKP();
#ifndef P2M
#define P2M 15
#endif
      {
        if (PROBE_DUP & 32) { { pg8::Gemm g{P.H0, P.WuqT, M, 768, 384, 768, 384}; pg8::StaticOrder S; S.init(M, 768, G, bx); EpiQ E{P.Q, P.SSQ, P.ROPE}; pg8::gemm_phase<EpiQ, pg8::StaticOrder>(lds, g, S, E); }
          { pg8::Gemm g{P.H0 + 384, P.WukvT, M, 1024, 256, 768, 256}; pg8::StaticOrder S; S.init(M, 1024, G, bx); EpiKV E{P.KV, P.SSQ}; pg8::gemm_phase<EpiKV, pg8::StaticOrder>(lds, g, S, E); } }
        if (P2M & 1) { pg8::Gemm g{P.H0, P.WuqT, M, 768, 384, 768, 384}; pg8::StaticOrder S; S.init(M, 768, G, bx); EpiQ E{P.Q, P.SSQ, P.ROPE};
          pg8::gemm_phase<EpiQ, pg8::StaticOrder>(lds, g, S, E); }
        if (P2M & 2) { pg8::Gemm g{P.H0 + 384, P.WukvT, M, 1024, 256, 768, 256}; pg8::StaticOrder S; S.init(M, 1024, G, bx); EpiKV E{P.KV, P.SSQ};
          pg8::gemm_phase<EpiKV, pg8::StaticOrder>(lds, g, S, E); }
        const bool xloc = !MK_SPLIT && MISC[12];
        const int kr0 = xloc ? ((vcu >> 5) * 8192 + (vcu & 31) * 512 + tid) : vcu * 512 + tid, kr1 = xloc ? (((vcu & 31) < 16) ? ((vcu >> 5) + 1) * 8192 : 0) : M * 4, krs = xloc ? 16384 : G * 512;
        if (P2M & 4) for (int i = kr0; i < kr1; i += krs) { const int m = i >> 2, gq = i & 3;
            const u32x2 a = *(const u32x2*)(P.H0 + (size_t)m * 768 + 640 + 4 * gq), bb = *(const u32x2*)(P.H0 + (size_t)m * 768 + 656 + 4 * gq);
            const f32x4 x1 = (f32x4){bflo(a.x), bfhi(a.x), bflo(a.y), bfhi(a.y)}, x2 = (f32x4){bflo(bb.x), bfhi(bb.x), bflo(bb.y), bfhi(bb.y)};
            const f32x4 c = *(const f32x4*)(P.ROPE + (size_t)m * 32 + 4 * gq), s = *(const f32x4*)(P.ROPE + (size_t)m * 32 + 16 + 4 * gq);
            *(u32x4*)(P.KR + (size_t)m * 32 + 8 * gq) = pack8(x1 * c - x2 * s, x2 * c + x1 * s); }
        __syncthreads();
      }
#if !MK_SPLIT
        if (MISC[12]) count_wait((unsigned*)(ws + WS_CTL) + CW_G1, MISC[9]);
#endif
#pragma unroll 1
        for (int rep = 0; rep < ((PROBE_DUP & 2) ? 2 : 1); ++rep)
        if (P2M & 8) for (int unit = vcu; unit < 256; unit += G) mlstm_pass1_unit(P, lds, unit >> 7, (unit >> 5) & 3, unit & 31, tid);
#if !MK_SPLIT
        if (MISC[12]) { if (IN(3)) xcd_local_barrier_post(bar, (unsigned*)(ws + WS_CTL) + CW_G2); }
        else
#endif
        SEAM(2);
    }
    if (IN(3)) { MKP(); mlstm_pass2(P, lds, vcu, G, tid);
#if !MK_SPLIT
        if (MISC[12]) {
            asm volatile("s_waitcnt vmcnt(0)" ::: "memory"); __syncthreads();
            if (tid == 0) (void)xb_add((unsigned*)(ws + WS_CTL) + CW_S3 + 64 * (bx & 7), 1u);
            count_wait((unsigned*)(ws + WS_CTL) + CW_G2, MISC[9]);
        } else
#endif
        SEAM(3); }
    if (IN(4)) { MKP();
#pragma unroll 1
        for (int rep = 0; rep < ((PROBE_DUP & 1) ? 2 : 1); ++rep)
#pragma unroll 1
        for (int i = 0; i < 2 * ((512 + 2 * G - 1) / (2 * G)); ++i) { const int un = (i >> 1) * 2 * G + vcu * 2 + (i & 1); if (un >= 512) break;
            const int bh = un >> 5, qb = un & 31, b = bh >> 3, h = bh & 7; const long rowb = (long)b * SEQ;
            att::attn_unit(P.Q + (rowb + qb * 256) * 768 + h * 96, P.KV + rowb * 1024 + h * 128, P.KR + rowb * 32, P.YA + (rowb + qb * 256) * 1024 + h * 64, lds); }
        __syncthreads();
#if !MK_SPLIT
        if (MISC[12]) count_wait((unsigned*)(ws + WS_CTL) + CW_S3 + 64 * (bx & 7), MISC[8]);
#endif
#pragma unroll 1
        for (int rep = 0; rep < ((PROBE_DUP & 512) ? 2 : 1); ++rep)
        for (int unit = vcu; unit < 256; unit += G) mlstm_pass3_unit(P, lds, unit >> 7, (unit >> 5) & 3, unit & 31, tid);
        SEAM(4);
    }
    if (IN(5)) { MKP();
      {
        { pg8::Gemm g{P.YA, P.WbmT, M, 1024, 1024, 1024, 1024}; pg8::StaticOrder S; S.init(M, 1024, G, bx); EpiMergeF E{P.MERGED, P.HG};
          pg8::gemm_phase<EpiMergeF, pg8::StaticOrder>(lds, g, S, E); }
      }
#if !MK_SPLIT
        if (IN(6) && MISC[12]) { asm volatile("s_waitcnt vmcnt(0)" ::: "memory"); __syncthreads(); if (tid == 0) (void)xb_add((unsigned*)(ws + WS_CTL) + CW_P5, 1u); }
#endif
        SEAML(5);
    }
    if (IN(6)) { MKP();
        pg8::Gemm g{P.MERGED, P.WoutT, M, 1024, 1024, 1024, 1024}; pg8::StaticOrder S; S.init(M, 1024, G, bx); EpiRes E{P.x, (G == 256) ? nullptr : P.out, P.X1B, P.SSQ1, true};
#pragma unroll 1
        for (int rep = 0; rep < ((PROBE_DUP & 128) ? 2 : 1); ++rep)
        pg8::gemm_phase<EpiRes, pg8::StaticOrder>(lds, g, S, E);
        SEAML(6);
#if !MK_SPLIT
        if (IN(7) && MISC[12]) { if (tid == 0) { unsigned* c5_ = (unsigned*)(ws + WS_CTL) + CW_P5; unsigned sp_ = 0;
              while (xb_ld(c5_) < (unsigned)G) { __builtin_amdgcn_s_sleep(2); if (++sp_ > (1u << 22)) break; }
              __builtin_amdgcn_fence(__ATOMIC_ACQUIRE, "agent"); asm volatile("s_waitcnt vmcnt(0)" ::: "memory"); }
          __syncthreads(); }
#endif
    }
    if (IN(7)) { MKP();
        pg8::Gemm g{P.X1B, P.WupT, M, DFF, 1024, 1024, 1024}; pg8::StaticOrder S; S.init(M, DFF, G, bx); EpiUp E{P.ACT, P.SSQ1};
#pragma unroll 1
        for (int rep = 0; rep < ((PROBE_DUP & 8) ? 2 : 1); ++rep)
        pg8::gemm_phase<EpiUp, pg8::StaticOrder>(lds, g, S, E);
        SEAML(7);
    }
    if (IN(8)) { MKP();
        pg8::Gemm g{P.ACT, P.WdnT, M, 1024, DFF, DFF, DFF}; pg8::StaticOrder S; S.init(M, 1024, G, bx);
        if (G == 256) {
            EpiFinal E{P.X1B, P.out, P.g_fin, P.SSQ2, (unsigned*)(ws + WS_CTL) + CW_CNT};
            pg8::gemm_phase<EpiFinal, pg8::StaticOrder>(lds, g, S, E);
        } else {
            EpiRes E{P.out, P.out, nullptr, P.SSQ2, false};
            pg8::gemm_phase<EpiRes, pg8::StaticOrder>(lds, g, S, E);
            SEAM(8);
        }
    }
    if (IN(9) && G != 256) { MKP(); int t9_ = tid; asm volatile("" : "+v"(t9_)); const int lane = t9_ & 63;
        for (int m = gw; m < M; m += NGW) { float ss = 0.f;
#pragma unroll
            for (int p = 0; p < 16; ++p) ss += P.SSQ2[(size_t)p * M + m];
            const float rstd = rsqrtf(ss * (1.f / 1024.f) + NORM_EPS);
            f32x4* xr = (f32x4*)(P.out + (size_t)m * 1024) + lane;
#pragma unroll
            for (int j = 0; j < 4; ++j) { const f32x4 g4 = *((const f32x4*)P.g_fin + lane + 64 * j); xr[64 * j] = xr[64 * j] * rstd * g4; } }
    }
#undef IN
#undef SEAM
}

extern "C" void kernel_launch(void* const* d_in, const int* in_sizes, int n_in, void* d_out, int out_size, void* d_ws, size_t ws_size, hipStream_t stream) {
    static int grid = 0;
    if (grid == 0) {
        if (n_in != 20 || in_sizes[0] != M * DMODEL || out_size != M * DMODEL || ws_size < WS_END) { fprintf(stderr, "kernel_launch: shape mismatch (n_in %d in0 %d out %d ws %zu)\n", n_in, n_in > 0 ? in_sizes[0] : -1, out_size, ws_size); grid = -1; return; }
        int dev = 0, cus = 0;
        if (hipGetDevice(&dev) != hipSuccess || hipDeviceGetAttribute(&cus, hipDeviceAttributeMultiprocessorCount, dev) != hipSuccess) { grid = -1; return; }
        if (hipFuncSetAttribute((const void*)mk_fwd, hipFuncAttributeMaxDynamicSharedMemorySize, LDS_BYTES) != hipSuccess) { fprintf(stderr, "kernel_launch: hipFuncSetAttribute failed\n"); grid = -1; return; }
        int per_cu = 0;
        if (hipOccupancyMaxActiveBlocksPerMultiprocessor(&per_cu, (const void*)mk_fwd, NWAVES * 64, LDS_BYTES) != hipSuccess || per_cu < 1) fprintf(stderr, "kernel_launch: occupancy query reports %d\n", per_cu);
        (void)hipGetLastError();
        grid = cus;
    }
    if (grid < 0) return;
    if (hipMemsetAsync((char*)d_ws + WS_CTL, 0, CTL_ZERO_BYTES, stream) != hipSuccess) { fprintf(stderr, "kernel_launch: memset failed\n"); return; }
    Args a{};
    for (int i = 0; i < 20; ++i) a.in[i] = d_in[i];
    a.out = (float*)d_out; a.ws = (unsigned char*)d_ws;
#if MK_SPLIT
    for (int li = 0; li < NPHASE; ++li) { a.ph_lo = li; a.ph_hi = li + 1; a.li = li;
        hipLaunchKernelGGL(mk_fwd, dim3(grid), dim3(NWAVES * 64), LDS_BYTES, stream, a); }
#else
    a.ph_lo = 0; a.ph_hi = NPHASE; a.li = 0;
    hipLaunchKernelGGL(mk_fwd, dim3(grid), dim3(NWAVES * 64), LDS_BYTES, stream, a);
#endif
    const hipError_t le = hipPeekAtLastError();
    if (le != hipSuccess) fprintf(stderr, "kernel_launch: launch failed: %s\n", hipGetErrorName(le));
}
```
